# Optimizing an MI355X kernel written in HIP

```python
import math
import jax
import jax.numpy as jnp
from jax import lax
import numpy as np

D_MODEL = 1024
BATCH = 8
SEQ = 4096
DEPTH = 2

GRID_W = 64
CTX_LEN = 256
N_EVEN = (DEPTH + 1) // 2
N_ODD = DEPTH // 2
N_MOD = 9
D_FF = 2816
NORM_EPS = 1e-6
MIX_WIDTH = D_MODEL
A_WIDTH = MIX_WIDTH // 2
A_HEADS = 4
A_QK_DIM = A_WIDTH // (2 * A_HEADS)
A_V_DIM = 2 * A_QK_DIM
B_WIDTH = MIX_WIDTH - A_WIDTH
AB_IN = 3 * A_WIDTH + 3 * B_WIDTH
HY_IN = 3 * B_WIDTH
HY_ORDER = 2
HY_SHORT = 3
HY_EMB = 33
HY_BANDS = (HY_EMB - 1) // 2
HY_FILTER_HID = 64
HY_INNER = 2
HY_FILTER_STD = 0.03
HY_TARGET = 1e-2
HY_MAX_DECAY = math.log(HY_TARGET) / 0.3
HY_MIN_DECAY = math.log(HY_TARGET) / 1.5
C_WIDTH = MIX_WIDTH
C_HEADS = 16
C_HEAD_DIM = C_WIDTH // C_HEADS
NA_ROWS_MAX = 8
NA_COLS = 16
ROPE_BASE = 10000.0
QBLOCK = 128

kernel_name = 'hybrid_diffattn_hyena_natten_macaron_dit'


def rmsnorm(x, w):
    xf = x.astype(jnp.float32)
    y = xf * lax.rsqrt(jnp.mean(xf * xf, axis=-1, keepdims=True) + NORM_EPS)
    return (y * w.astype(jnp.float32)).astype(x.dtype)


def adaln_in(h, gain, mod, k):
    return rmsnorm(h, gain) * (1.0 + mod[:, 3 * k + 1]) + mod[:, 3 * k]


def swiglu(h, w1, w3, w2):
    return (jax.nn.silu(h @ w1) * (h @ w3)) @ w2


def macaron(h, gain, mod, k, w1, w3, w2):
    return h + 0.5 * mod[:, 3 * k + 2] * swiglu(adaln_in(h, gain, mod, k), w1, w3, w2)


def axial_rope(x):
    n = x.shape[1]
    t = jnp.arange(n)
    pos = (t // GRID_W, t % GRID_W)
    half = x.shape[-1] // 2
    nf = half // 2
    inv_freq = ROPE_BASE ** (-jnp.arange(nf, dtype=jnp.float32) / nf)
    bshape = (1, n) + (1,) * (x.ndim - 3) + (nf,)
    parts = []
    for a in range(2):
        ang = pos[a].astype(jnp.float32)[:, None] * inv_freq
        cos = jnp.cos(ang).reshape(bshape).astype(x.dtype)
        sin = jnp.sin(ang).reshape(bshape).astype(x.dtype)
        xa = x[..., a * half:(a + 1) * half]
        x1, x2 = xa[..., :nf], xa[..., nf:]
        parts += [x1 * cos - x2 * sin, x1 * sin + x2 * cos]
    return jnp.concatenate(parts, axis=-1)


def diff_attend(q, k, v, lam):
    s = jnp.einsum('bqhmd,bkhmd->bhmqk', q, k).astype(jnp.float32) * (A_QK_DIM ** -0.5)
    p = jax.nn.softmax(s, axis=-1)
    a = (p[:, :, 0] - lam * p[:, :, 1]).astype(v.dtype)
    return jnp.einsum('bhqk,bkhd->bqhd', a, v)


def plain_attend(q, k, v):
    s = jnp.einsum('bqhd,bkhd->bhqk', q, k).astype(jnp.float32) * (q.shape[-1] ** -0.5)
    p = jax.nn.softmax(s, axis=-1).astype(v.dtype)
    return jnp.einsum('bhqk,bkhd->bqhd', p, v)


def short_conv(u, w, b):
    n = u.shape[1]
    pad = HY_SHORT // 2
    up = jnp.pad(u, ((0, 0), (pad, pad), (0, 0)))
    return sum(up[:, j:j + n] * w[j] for j in range(HY_SHORT)) + b


def hyena_filters(n, f_w0, f_b0, f_w1, f_b1, f_freq, f_wout):
    t = jnp.linspace(0.0, 1.0, n, dtype=jnp.float32)[:, None]
    w = (2.0 * math.pi / n) * jnp.arange(n, dtype=jnp.float32)[:, None]
    bands = jnp.linspace(1e-4, HY_BANDS - 1, HY_BANDS, dtype=jnp.float32)[None, :]
    z = jnp.concatenate([t, jnp.cos(bands * w), -jnp.sin(bands * w)], axis=-1)
    hid = jnp.sin(f_freq * (z @ f_w0 + f_b0))
    for i in range(HY_INNER):
        hid = jnp.sin(f_freq * (hid @ f_w1[i] + f_b1[i]))
    filt = (hid @ f_wout).reshape(n, HY_ORDER, 2, B_WIDTH)
    deltas = jnp.abs(jnp.linspace(HY_MIN_DECAY, HY_MAX_DECAY, B_WIDTH, dtype=jnp.float32))
    window = jnp.exp(-t * deltas)
    return filt * window[:, None, None, :]


def long_conv_bidir(v, h_fwd, h_bwd, skip):
    n = v.shape[1]
    taps = jnp.concatenate([h_fwd, jnp.zeros_like(h_fwd[:1]), h_bwd[:0:-1]], axis=0)
    taps_f = jnp.fft.rfft(taps.astype(jnp.float32), n=2 * n, axis=0)
    v_f = jnp.fft.rfft(v.astype(jnp.float32), n=2 * n, axis=1)
    y = jnp.fft.irfft(v_f * taps_f[None], n=2 * n, axis=1)[:, :n]
    return (y + v.astype(jnp.float32) * skip.astype(jnp.float32)).astype(v.dtype)


def hyena(u, conv_w, conv_b, f_w0, f_b0, f_w1, f_b1, f_freq, f_wout, hy_b):
    n = u.shape[1]
    u = short_conv(u, conv_w, conv_b)
    x1, x2, v = jnp.split(u, 3, axis=-1)
    filt = hyena_filters(n, f_w0, f_b0, f_w1, f_b1, f_freq, f_wout)
    z = x1 * long_conv_bidir(v, filt[:, 0, 0], filt[:, 0, 1], hy_b[0])
    z = x2 * long_conv_bidir(z, filt[:, 1, 0], filt[:, 1, 1], hy_b[1])
    return z


def mixer_ab(h_lat, h_ctx, w_in, w_out, lam_p, subln_w, conv_w, conv_b,
             f_w0, f_b0, f_w1, f_b1, f_freq, f_wout, hy_b, layer, need_ctx):
    bsz, n, _ = h_lat.shape
    n_ctx = h_ctx.shape[1]
    lam_init = 0.8 - 0.6 * math.exp(-0.3 * layer)
    lam = (jnp.exp(jnp.sum(lam_p[0] * lam_p[1]).astype(jnp.float32))
           - jnp.exp(jnp.sum(lam_p[2] * lam_p[3]).astype(jnp.float32)) + lam_init)

    def head_out(o):
        return (rmsnorm(o, subln_w) * (1.0 - lam_init)).reshape(o.shape[0], o.shape[1], A_WIDTH)

    def hy(u):
        return hyena(u, conv_w, conv_b, f_w0, f_b0, f_w1, f_b1, f_freq, f_wout, hy_b)

    u_l = h_lat @ w_in
    q_l = axial_rope(u_l[..., :A_WIDTH].reshape(bsz, n, A_HEADS, 2, A_QK_DIM))
    k_l = axial_rope(u_l[..., A_WIDTH:2 * A_WIDTH].reshape(bsz, n, A_HEADS, 2, A_QK_DIM))
    v_l = u_l[..., 2 * A_WIDTH:3 * A_WIDTH].reshape(bsz, n, A_HEADS, A_V_DIM)
    if need_ctx:
        u_c = h_ctx @ w_in
        kv_c = u_c[..., A_WIDTH:3 * A_WIDTH]
    else:
        kv_c = h_ctx @ w_in[:, A_WIDTH:3 * A_WIDTH]
    k_c = kv_c[..., :A_WIDTH].reshape(bsz, n_ctx, A_HEADS, 2, A_QK_DIM)
    v_c = kv_c[..., A_WIDTH:].reshape(bsz, n_ctx, A_HEADS, A_V_DIM)
    k_all = jnp.concatenate([k_c, k_l], axis=1)
    v_all = jnp.concatenate([v_c, v_l], axis=1)
    nb = n // QBLOCK
    q_blk = q_l.reshape(bsz, nb, QBLOCK, A_HEADS, 2, A_QK_DIM).swapaxes(0, 1)
    o_l = lax.map(lambda qb: diff_attend(qb, k_all, v_all, lam), q_blk)
    a_l = head_out(o_l.swapaxes(0, 1).reshape(bsz, n, A_HEADS, A_V_DIM))
    b_l = hy(u_l[..., 3 * A_WIDTH:])
    y_l = jnp.concatenate([a_l, b_l], axis=-1) @ w_out
    y_c = None
    if need_ctx:
        q_c = u_c[..., :A_WIDTH].reshape(bsz, n_ctx, A_HEADS, 2, A_QK_DIM)
        a_c = head_out(diff_attend(q_c, k_c, v_c, lam))
        b_c = hy(u_c[..., 3 * A_WIDTH:])
        y_c = jnp.concatenate([a_c, b_c], axis=-1) @ w_out
    return y_l, y_c


def neighbourhood_attention(q, k, v, k_ctx, v_ctx, rpb):
    bsz, n, nh, dh = q.shape
    rows = n // GRID_W
    kr = min(NA_ROWS_MAX, rows)
    kc = NA_COLS
    scale = dh ** -0.5
    qg = q.reshape(bsz, rows, GRID_W, nh, dh)
    kg = k.reshape(bsz, rows, GRID_W, nh, dh)
    vg = v.reshape(bsz, rows, GRID_W, nh, dh)
    cols = jnp.arange(GRID_W)
    col_start = jnp.clip(cols - kc // 2, 0, GRID_W - kc)
    col_idx = col_start[:, None] + jnp.arange(kc)[None, :]
    col_off = col_idx - cols[:, None] + (NA_COLS - 1)
    rpb_cols = rpb[:, :, col_off]

    def row_step(args):
        r, q_row = args
        rs = jnp.clip(r - kr // 2, 0, rows - kr)
        k_nb = lax.dynamic_slice_in_dim(kg, rs, kr, axis=1)[:, :, col_idx]
        v_nb = lax.dynamic_slice_in_dim(vg, rs, kr, axis=1)[:, :, col_idx]
        row_off = rs + jnp.arange(kr) - r + (NA_ROWS_MAX - 1)
        bias = rpb_cols[:, row_off].transpose(0, 2, 1, 3)
        s_lat = jnp.einsum('bchd,brckhd->bhcrk', q_row, k_nb).astype(jnp.float32) * scale + bias
        s_ctx = jnp.einsum('bchd,bkhd->bhck', q_row, k_ctx).astype(jnp.float32) * scale
        s = jnp.concatenate([s_lat.reshape(bsz, nh, GRID_W, kr * kc), s_ctx], axis=-1)
        p = jax.nn.softmax(s, axis=-1).astype(v.dtype)
        p_lat = p[..., :kr * kc].reshape(bsz, nh, GRID_W, kr, kc)
        return (jnp.einsum('bhcrk,brckhd->bchd', p_lat, v_nb)
                + jnp.einsum('bhck,bkhd->bchd', p[..., kr * kc:], v_ctx))

    out = lax.map(row_step, (jnp.arange(rows), qg.swapaxes(0, 1)))
    return out.swapaxes(0, 1).reshape(bsz, n, nh * dh)


def mixer_c(h_lat, h_ctx, w_in, w_out, rpb, need_ctx):
    bsz, n, _ = h_lat.shape
    n_ctx = h_ctx.shape[1]
    u_l = (h_lat @ w_in).reshape(bsz, n, 3, C_HEADS, C_HEAD_DIM)
    if need_ctx:
        u_c = (h_ctx @ w_in).reshape(bsz, n_ctx, 3, C_HEADS, C_HEAD_DIM)
        k_c, v_c = u_c[:, :, 1], u_c[:, :, 2]
    else:
        kv_c = (h_ctx @ w_in[:, C_WIDTH:]).reshape(bsz, n_ctx, 2, C_HEADS, C_HEAD_DIM)
        k_c, v_c = kv_c[:, :, 0], kv_c[:, :, 1]
    o_l = neighbourhood_attention(u_l[:, :, 0], u_l[:, :, 1], u_l[:, :, 2], k_c, v_c, rpb)
    y_l = o_l @ w_out
    y_c = None
    if need_ctx:
        y_c = plain_attend(u_c[:, :, 0], k_c, v_c).reshape(bsz, n_ctx, C_WIDTH) @ w_out
    return y_l, y_c


def setup_inputs(seed: int = 0) -> dict:
    key = jax.random.key(seed)
    ks = jax.random.split(key, 27)
    f32 = jnp.float32
    D = D_MODEL

    def nrm(k, shape, scale):
        return jax.random.normal(k, shape, f32) * scale

    return {
        'x': nrm(ks[0], (BATCH, SEQ, D), 1.0),
        'c': nrm(ks[1], (BATCH, D), 1.0),
        'ctx': nrm(ks[2], (BATCH, CTX_LEN, D), 1.0),
        'c_ctx': nrm(ks[3], (D,), 1.0),
        'mod_w': nrm(ks[4], (DEPTH, D, N_MOD * D), 0.5 * D ** -0.5),
        'mod_b': nrm(ks[5], (DEPTH, N_MOD * D), 0.02),
        'norm_w': 1.0 + nrm(ks[6], (DEPTH, 3, D), 0.02),
        'ffn_w1': nrm(ks[7], (DEPTH, 2, D, D_FF), D ** -0.5),
        'ffn_w3': nrm(ks[8], (DEPTH, 2, D, D_FF), D ** -0.5),
        'ffn_w2': nrm(ks[9], (DEPTH, 2, D_FF, D), D_FF ** -0.5),
        'ab_w_in': nrm(ks[10], (N_EVEN, D, AB_IN), D ** -0.5),
        'ab_w_out': nrm(ks[11], (N_EVEN, MIX_WIDTH, D), MIX_WIDTH ** -0.5),
        'diff_lambda': nrm(ks[12], (N_EVEN, 4, A_QK_DIM), 0.1),
        'diff_subln_w': 1.0 + nrm(ks[13], (N_EVEN, A_V_DIM), 0.02),
        'hy_conv_w': nrm(ks[14], (N_EVEN, HY_SHORT, HY_IN), HY_SHORT ** -0.5),
        'hy_conv_b': nrm(ks[15], (N_EVEN, HY_IN), 0.02),
        'hy_f_w0': nrm(ks[16], (N_EVEN, HY_EMB, HY_FILTER_HID), HY_EMB ** -0.5),
        'hy_f_b0': nrm(ks[17], (N_EVEN, HY_FILTER_HID), 0.1),
        'hy_f_w1': nrm(ks[18], (N_EVEN, HY_INNER, HY_FILTER_HID, HY_FILTER_HID), HY_FILTER_HID ** -0.5),
        'hy_f_b1': nrm(ks[19], (N_EVEN, HY_INNER, HY_FILTER_HID), 0.1),
        'hy_f_freq': 1.0 + nrm(ks[20], (N_EVEN, HY_FILTER_HID), 0.1),
        'hy_f_wout': nrm(ks[21], (N_EVEN, HY_FILTER_HID, HY_ORDER * 2 * B_WIDTH), HY_FILTER_STD * HY_FILTER_HID ** -0.5),
        'hy_bias': nrm(ks[22], (N_EVEN, HY_ORDER, B_WIDTH), 0.5),
        'na_w_in': nrm(ks[23], (N_ODD, D, 3 * C_WIDTH), D ** -0.5),
        'na_w_out': nrm(ks[24], (N_ODD, C_WIDTH, D), C_WIDTH ** -0.5),
        'na_rpb': nrm(ks[25], (N_ODD, C_HEADS, 2 * NA_ROWS_MAX - 1, 2 * NA_COLS - 1), 0.02),
        'final_norm_w': 1.0 + nrm(ks[26], (D,), 0.02),
    }


def reference(x, c, ctx, c_ctx, mod_w, mod_b, norm_w, ffn_w1, ffn_w3, ffn_w2,
              ab_w_in, ab_w_out, diff_lambda, diff_subln_w, hy_conv_w, hy_conv_b,
              hy_f_w0, hy_f_b0, hy_f_w1, hy_f_b1, hy_f_freq, hy_f_wout, hy_bias,
              na_w_in, na_w_out, na_rpb, final_norm_w):
    bsz = x.shape[0]
    lat, cx = x, ctx
    s_l = jax.nn.silu(c)
    s_c = jax.nn.silu(c_ctx)[None]
    for layer in range(DEPTH):
        need_ctx = layer < DEPTH - 1
        mod_l = (s_l @ mod_w[layer] + mod_b[layer]).reshape(bsz, N_MOD, 1, D_MODEL)
        mod_c = (s_c @ mod_w[layer] + mod_b[layer]).reshape(1, N_MOD, 1, D_MODEL)
        g = norm_w[layer]
        f0 = (ffn_w1[layer, 0], ffn_w3[layer, 0], ffn_w2[layer, 0])
        f1 = (ffn_w1[layer, 1], ffn_w3[layer, 1], ffn_w2[layer, 1])
        lat = macaron(lat, g[0], mod_l, 0, *f0)
        cx = macaron(cx, g[0], mod_c, 0, *f0)
        h_l = adaln_in(lat, g[1], mod_l, 1)
        h_c = adaln_in(cx, g[1], mod_c, 1)
        if layer % 2 == 0:
            i = layer // 2
            y_l, y_c = mixer_ab(h_l, h_c, ab_w_in[i], ab_w_out[i], diff_lambda[i], diff_subln_w[i],
                                hy_conv_w[i], hy_conv_b[i], hy_f_w0[i], hy_f_b0[i], hy_f_w1[i],
                                hy_f_b1[i], hy_f_freq[i], hy_f_wout[i], hy_bias[i], layer, need_ctx)
        else:
            i = layer // 2
            y_l, y_c = mixer_c(h_l, h_c, na_w_in[i], na_w_out[i], na_rpb[i], need_ctx)
        lat = macaron(lat + mod_l[:, 5] * y_l, g[2], mod_l, 2, *f1)
        if need_ctx:
            cx = macaron(cx + mod_c[:, 5] * y_c, g[2], mod_c, 2, *f1)
    return rmsnorm(lat, final_norm_w)
```

```cpp
#include <hip/hip_runtime.h>
#include <hip/hip_cooperative_groups.h>
#include <cstdio>
namespace cg = cooperative_groups;

#define DI __device__ __forceinline__
#define LAS __attribute__((address_space(3)))
typedef unsigned short bf16_t;
typedef short bf16x8 __attribute__((ext_vector_type(8)));
typedef float f32x4 __attribute__((ext_vector_type(4)));
typedef float f32x16 __attribute__((ext_vector_type(16)));
typedef unsigned u32x4 __attribute__((ext_vector_type(4)));
typedef unsigned u32x2 __attribute__((ext_vector_type(2)));

constexpr int D = 1024, SEQ = 4096, NB = 8, NCTX = 256, DFF = 2816;
constexpr int ML = NB * SEQ, MC = NB * NCTX, MT = ML + MC;
constexpr int NMOD = 9;
constexpr int LDS_BYTES = 131072;
constexpr int LDS_TOTAL = 163840;
constexpr int LDS_XST = LDS_TOTAL - 16;

constexpr size_t AL(size_t x) { return (x + 255) & ~(size_t)255; }
constexpr size_t WS_CTXS = 0;
constexpr size_t WS_HN   = AL(WS_CTXS + (size_t)MC * D * 4);
constexpr size_t WS_BIG  = AL(WS_HN + (size_t)MT * D * 2);
constexpr size_t BIG_SZ  = (size_t)MT * 1024 * 2 + (size_t)2048 * MT * 2;
constexpr size_t WS_BT   = AL(WS_BIG + BIG_SZ);
constexpr size_t WS_W13T = AL(WS_BT + (size_t)512 * MT * 2);
constexpr size_t WS_W2T  = AL(WS_W13T + (size_t)4 * 5632 * 1024 * 2);
constexpr size_t WS_ABIN = AL(WS_W2T + (size_t)4 * 1024 * 2816 * 2);
constexpr size_t WS_ABOUT= AL(WS_ABIN + (size_t)3072 * 1024 * 2);
constexpr size_t WS_NAIN = AL(WS_ABOUT + (size_t)1024 * 1024 * 2);
constexpr size_t WS_NAOUT= AL(WS_NAIN + (size_t)3072 * 1024 * 2);
constexpr size_t WS_MOD  = AL(WS_NAOUT + (size_t)1024 * 1024 * 2);
constexpr size_t WS_ROPE = AL(WS_MOD + (size_t)2 * 9 * 9216 * 4);
constexpr size_t WS_HL   = AL(WS_ROPE + 64 * 16 * 2 * 4);
constexpr size_t WS_HC   = AL(WS_HL + (size_t)2048 * 4096 * 2);
constexpr size_t WS_BAR  = AL(WS_HC + (size_t)2048 * 256 * 2);
constexpr size_t WS_XS   = AL(WS_BAR + 3456 * 4);
constexpr size_t WS_END  = AL(WS_XS + (size_t)MT * D * 2);

struct Params {
    const float* in[27];
    float* out;
    unsigned char* ws;
    int ph_lo, ph_hi;
};

typedef const __attribute__((address_space(4))) Params* PP;

DI unsigned pk2(float a, float b) {
    typedef __bf16 bf2 __attribute__((ext_vector_type(2)));
    typedef float f2 __attribute__((ext_vector_type(2)));
    f2 v = {a, b};
    return __builtin_bit_cast(unsigned, __builtin_convertvector(v, bf2));
}
DI float bf2f(bf16_t h) { return __uint_as_float(((unsigned)h) << 16); }
DI float bflo(unsigned u) { return __uint_as_float(u << 16); }
DI float bfhi(unsigned u) { return __uint_as_float(u & 0xffff0000u); }
DI bf16_t f2bf(float f) { return (bf16_t)(pk2(f, 0.f) & 0xffffu); }
DI u32x4 zero4() { unsigned z = 0u; asm volatile("" : "+v"(z)); return (u32x4){z, z, z, z}; }
DI float shx(float v, int lane, int m) { return __builtin_bit_cast(float, __builtin_amdgcn_ds_bpermute((lane ^ m) << 2, __builtin_bit_cast(int, v))); }
DI float wave_sum(float v, int lane) {
#pragma unroll
    for (int o = 32; o >= 1; o >>= 1) v += shx(v, lane, o);
    return v;
}
DI float silu_f(float x) { return x * __builtin_amdgcn_rcpf(1.f + __expf(-x)); }
DI int tidx() { int t = threadIdx.x; asm volatile("" : "+v"(t)); return t; }
DI float sin_turns(float x) { return __builtin_amdgcn_sinf(x - floorf(x)); }
DI float cos_turns(float x) { return __builtin_amdgcn_cosf(x - floorf(x)); }
DI float sin_rad(float x) { return sin_turns(x * 0.15915494309189535f); }
DI int kperm(int m) { return (m & ~12) | ((m & 8) >> 1) | ((m & 4) << 1); }

namespace pg8 {
constexpr int BM = 256, BK = 64, HALF = 128, HTB = HALF * BK * 2, STAGE_BYTES = 8 * HTB, NXCD = 8, WGM = 8;
DI int lds_byte(int r, int c) { const int st = (r >> 4) * 2 + (c >> 5), rr = r & 15, cc = c & 31, ob = rr * 64 + cc * 2; return st * 1024 + (ob ^ (((ob >> 9) & 1) << 5)); }
DI void stage_rc(int b, int& R, int& C) { const int st = b / 1024, sb = b % 1024, swz = sb ^ (((sb >> 9) & 1) << 5); R = (st >> 1) * 16 + swz / 64; C = (st & 1) * 32 + (swz % 64) / 2; }
DI int perm32(int rho) { const int n = rho >> 4, i = rho & 15; return 8 * (i >> 2) + 4 * n + (i & 3); }
struct Unit { int pm, pn, ko; };
struct Gemm { const bf16_t* A; const bf16_t* Bt; int M, N, K, ld; };
struct StaticOrder {
    int nM, nN, nwg, G, c;
    DI void init(int M, int N, int G_, int c_) { nM = M / BM; nN = N / BM; nwg = nM * nN; G = G_; c = c_; }
    DI bool next(int i, Unit& u) const {
        const long L = (long)i * G + c; if (L >= nwg) return false;
        int wgid = (int)L; { const int q = nwg / NXCD, r = nwg % NXCD, xcd = wgid % NXCD, off = wgid / NXCD; wgid = (xcd < r ? xcd * (q + 1) : r * (q + 1) + (xcd - r) * q) + off; }
        const int nig = WGM * nN, gid = wgid / nig, fm = gid * WGM, gsz = (nM - fm) < WGM ? (nM - fm) : WGM;
        u.pm = fm + ((wgid % nig) % gsz); u.pn = (wgid % nig) / gsz; u.ko = 0; return true;
    }
};

template <int NKC> struct SplitKOrder {
    int pm0, nun, G, c;
    DI void init(int pm0_, int npm, int G_, int c_) { pm0 = pm0_; nun = npm * 4 * NKC; G = G_; c = c_; }
    DI bool next(int i, Unit& u) const { const int L = i * G + c; if (L >= nun) return false; u.ko = (L % NKC) * 256; const int q = L / NKC; u.pn = q & 3; u.pm = pm0 + (q >> 2); return true; }
};

template <class Epi, class Sched>
DI void gemm_phase(LAS unsigned char* lds, const Gemm g, const Sched& S, const Epi& E) {
    const int tid = tidx(), wid = __builtin_amdgcn_readfirstlane(tid >> 6), lane = tid & 63, wr = wid >> 2, wc = wid & 3, fr = lane & 15, fq = lane >> 4;
    const int K = g.K, nt = K / BK;
    unsigned voffA[2], voffB[2];
#pragma unroll
    for (int i = 0; i < 2; ++i) { int R, C; stage_rc(tid * 16 + i * 8192, R, C); const int Rb = Epi::PERM ? ((R & ~31) + perm32(R & 31)) : R;
        voffA[i] = (unsigned)(R * g.ld + C) * 2u; voffB[i] = (unsigned)(Rb * g.ld + C) * 2u; }
    const size_t kstep = (size_t)(BK * 2);
    const size_t hstep = (size_t)HALF * g.ld * 2;
    const size_t tstep = 2 * hstep;
    const unsigned ldsw = (unsigned)wid * 1024u;
    const int aoff = lds_byte(wr * 64 + fr, fq * 8), boff = lds_byte(wc * 32 + fr, fq * 8);
#define PG8_SA(b, h) (((b) * 2 + (h)) * HTB)
#define PG8_SB(b, h) ((4 + (b) * 2 + (h)) * HTB)
#define PG8_STAGE(bufoff, gbase, voff) do { _Pragma("unroll") for (int _i = 0; _i < 2; ++_i) \
        __builtin_amdgcn_global_load_lds((const unsigned*)((const char*)(gbase) + (voff)[_i]), (LAS unsigned*)(lds + (bufoff) + ldsw + _i * 8192), 16, 0, 0); } while (0)
#define PG8_LDA(dst, b, h) do { _Pragma("unroll") for (int m = 0; m < 4; ++m) _Pragma("unroll") for (int k = 0; k < 2; ++k) dst[m][k] = *(const LAS bf16x8*)(lds + PG8_SA(b, h) + aoff + m * 2048 + k * 1024); } while (0)
#define PG8_LDB(dst, b, h) do { _Pragma("unroll") for (int n = 0; n < 2; ++n) _Pragma("unroll") for (int k = 0; k < 2; ++k) dst[n][k] = *(const LAS bf16x8*)(lds + PG8_SB(b, h) + boff + n * 2048 + k * 1024); } while (0)
#define PG8_MMA(ai, bj, At, Bt) do { __builtin_amdgcn_s_setprio(1); _Pragma("unroll") for (int m = 0; m < 4; ++m) _Pragma("unroll") for (int n = 0; n < 2; ++n) _Pragma("unroll") for (int k = 0; k < 2; ++k) \
        acc[ai][bj][m][n] = __builtin_amdgcn_mfma_f32_16x16x32_bf16(Bt[n][k], At[m][k], acc[ai][bj][m][n], 0, 0, 0); __builtin_amdgcn_s_setprio(0); } while (0)
#define PG8_WAIT_V(n) asm volatile("s_waitcnt vmcnt(" #n ")" ::: "memory")
#define PG8_WAIT_L(n) asm volatile("s_waitcnt lgkmcnt(" #n ")" ::: "memory")
#define PG8_BAR __builtin_amdgcn_s_barrier()
#define PG8_SCHED __builtin_amdgcn_sched_barrier(0)
    Unit cur, nxt; int ui = 0;
    if (!S.next(0, cur)) return;
    f32x4 acc[2][2][4][2];
#pragma unroll
    for (int a = 0; a < 2; ++a)
#pragma unroll
        for (int b = 0; b < 2; ++b)
#pragma unroll
            for (int m = 0; m < 4; ++m)
#pragma unroll
                for (int n = 0; n < 2; ++n) acc[a][b][m][n] = (f32x4){0.f, 0.f, 0.f, 0.f};
    bf16x8 At[4][2], B0[2][2], B1[2][2];
    const char* cA = (const char*)g.A + (size_t)cur.pm * tstep + (size_t)cur.ko * 2; const char* cB = (const char*)g.Bt + (size_t)cur.pn * tstep + (size_t)cur.ko * 2;
    PG8_STAGE(PG8_SB(0, 0), cB, voffB); PG8_STAGE(PG8_SA(0, 0), cA, voffA); PG8_STAGE(PG8_SB(0, 1), cB + hstep, voffB); PG8_STAGE(PG8_SA(0, 1), cA + hstep, voffA);
    if (wr == 1) PG8_BAR;
    PG8_WAIT_V(4); PG8_BAR;
    PG8_STAGE(PG8_SB(1, 0), cB + kstep, voffB); PG8_STAGE(PG8_SA(1, 0), cA + kstep, voffA); PG8_STAGE(PG8_SB(1, 1), cB + hstep + kstep, voffB);
    PG8_WAIT_V(6); PG8_BAR;
    for (;;) {
        const bool has_next = S.next(ui + 1, nxt);
        const char* nA = has_next ? (const char*)g.A + (size_t)nxt.pm * tstep + (size_t)nxt.ko * 2 : cA; const char* nB = has_next ? (const char*)g.Bt + (size_t)nxt.pn * tstep + (size_t)nxt.ko * 2 : cB;
#pragma unroll 1
        for (int t = 0; t < nt; t += 2) {
            const bool last = (t == nt - 2);
            const char* a1 = cA + (size_t)(t + 1) * kstep;
            const char* a2 = last ? nA : cA + (size_t)(t + 2) * kstep; const char* b2 = last ? nB : cB + (size_t)(t + 2) * kstep;
            const char* a3 = a2 + kstep; const char* b3 = b2 + kstep;
            PG8_LDB(B0, 0, 0); PG8_SCHED; PG8_LDA(At, 0, 0); PG8_STAGE(PG8_SA(1, 1), a1 + hstep, voffA);
            PG8_WAIT_L(8); PG8_BAR; PG8_WAIT_L(0); PG8_MMA(0, 0, At, B0); PG8_BAR; PG8_SCHED;
            PG8_LDB(B1, 0, 1); PG8_STAGE(PG8_SB(0, 0), b2, voffB);
            PG8_BAR; PG8_WAIT_L(0); PG8_MMA(0, 1, At, B1); PG8_BAR;
            PG8_LDA(At, 0, 1); PG8_STAGE(PG8_SA(0, 0), a2, voffA);
            PG8_BAR; PG8_WAIT_L(0); PG8_MMA(1, 0, At, B0); PG8_BAR; PG8_SCHED;
            PG8_STAGE(PG8_SB(0, 1), b2 + hstep, voffB);
            PG8_WAIT_V(6); PG8_BAR; PG8_MMA(1, 1, At, B1); PG8_BAR;
            PG8_LDB(B0, 1, 0); PG8_SCHED; PG8_LDA(At, 1, 0); PG8_STAGE(PG8_SA(0, 1), a2 + hstep, voffA);
            PG8_WAIT_L(8); PG8_BAR; PG8_WAIT_L(0); PG8_MMA(0, 0, At, B0); PG8_BAR; PG8_SCHED;
            PG8_LDB(B1, 1, 1); PG8_STAGE(PG8_SB(1, 0), b3, voffB);
            PG8_BAR; PG8_WAIT_L(0); PG8_MMA(0, 1, At, B1); PG8_BAR;
            PG8_LDA(At, 1, 1); PG8_STAGE(PG8_SA(1, 0), a3, voffA);
            PG8_BAR; PG8_WAIT_L(0); PG8_MMA(1, 0, At, B0); PG8_BAR; PG8_SCHED;
            PG8_STAGE(PG8_SB(1, 1), b3 + hstep, voffB);
            PG8_WAIT_V(6); PG8_BAR; PG8_MMA(1, 1, At, B1); PG8_BAR;
        }
        E(acc, cur, wr, wc, fr, fq);
        if (!has_next) break;
#pragma unroll
        for (int a = 0; a < 2; ++a)
#pragma unroll
            for (int b = 0; b < 2; ++b)
#pragma unroll
                for (int m = 0; m < 4; ++m)
#pragma unroll
                    for (int n = 0; n < 2; ++n) acc[a][b][m][n] = (f32x4){0.f, 0.f, 0.f, 0.f};
        cur = nxt; cA = nA; cB = nB; ++ui;
    }
    PG8_WAIT_V(0);
    if (wr == 0) PG8_BAR;
    PG8_BAR;
#undef PG8_SA
#undef PG8_SB
#undef PG8_STAGE
#undef PG8_LDA
#undef PG8_LDB
#undef PG8_MMA
#undef PG8_WAIT_V
#undef PG8_WAIT_L
#undef PG8_BAR
#undef PG8_SCHED
}

struct EpiSwiglu {
    static constexpr bool PERM = true;
    bf16_t* H;
    DI void operator()(const f32x4 (&acc)[2][2][4][2], const Unit& u, int wr, int wc, int fr, int fq) const {
        const int row0 = u.pm * BM + wr * 64 + fr, col0 = u.pn * 128 + wc * 32 + 8 * fq;
#pragma unroll
        for (int ai = 0; ai < 2; ++ai)
#pragma unroll
            for (int m = 0; m < 4; ++m) {
                const f32x4 g0 = acc[ai][0][m][0], g1 = acc[ai][0][m][1], u0 = acc[ai][1][m][0], u1 = acc[ai][1][m][1];
                u32x4 o;
                o[0] = pk2(silu_f(g0[0]) * u0[0], silu_f(g0[1]) * u0[1]); o[1] = pk2(silu_f(g0[2]) * u0[2], silu_f(g0[3]) * u0[3]);
                o[2] = pk2(silu_f(g1[0]) * u1[0], silu_f(g1[1]) * u1[1]); o[3] = pk2(silu_f(g1[2]) * u1[2], silu_f(g1[3]) * u1[3]);
                *(u32x4*)(H + (size_t)(row0 + ai * HALF + m * 16) * DFF + col0) = o;
            }
    }
};
template <bool ATOMIC> struct EpiResidT {
    static constexpr bool PERM = true;
    bf16_t* lat; bf16_t* ctxs; const float* gate; float f;
    DI void operator()(const f32x4 (&acc)[2][2][4][2], const Unit& u, int wr, int wc, int fr, int fq) const {
        const int rt = u.pm * BM; const bool islat = rt < ML; const int bb = islat ? (rt >> 12) : 8;
        bf16_t* base = islat ? lat + (size_t)rt * D : ctxs + (size_t)(rt - ML) * D;
        const int col0 = u.pn * BM + wc * 32 + 8 * fq;
        const float* g = gate + (size_t)bb * (NMOD * D) + col0;
        f32x4 gv[2][2];
#pragma unroll
        for (int bj = 0; bj < 2; ++bj) { gv[bj][0] = *(const f32x4*)(g + bj * HALF) * f; gv[bj][1] = *(const f32x4*)(g + bj * HALF + 4) * f; }
        bf16_t* xp = base + (size_t)(wr * 64 + fr) * D + col0;
#pragma unroll
        for (int ai = 0; ai < 2; ++ai) {
            asm volatile("" : "+v"(xp));
            u32x4 xv[4][2];
#pragma unroll
            for (int m = 0; m < 4; ++m)
#pragma unroll
                for (int bj = 0; bj < 2; ++bj) xv[m][bj] = *(const u32x4*)(xp + (size_t)m * 16 * D + bj * HALF);
#pragma unroll
            for (int m = 0; m < 4; ++m)
#pragma unroll
                for (int bj = 0; bj < 2; ++bj) {
                    const f32x4 d0 = gv[bj][0] * acc[ai][bj][m][0], d1 = gv[bj][1] * acc[ai][bj][m][1];
                    const u32x4 x = xv[m][bj]; u32x4 ov;
                    ov[0] = pk2(bflo(x[0]) + d0[0], bfhi(x[0]) + d0[1]); ov[1] = pk2(bflo(x[1]) + d0[2], bfhi(x[1]) + d0[3]);
                    ov[2] = pk2(bflo(x[2]) + d1[0], bfhi(x[2]) + d1[1]); ov[3] = pk2(bflo(x[3]) + d1[2], bfhi(x[3]) + d1[3]);
                    if (!ATOMIC) *(u32x4*)(xp + (size_t)m * 16 * D + bj * HALF) = ov;
                }
            xp += 128 * D;
        }
    }
};
typedef EpiResidT<false> EpiResid;
struct EpiRope {
    static constexpr bool PERM = false;
    bf16_t* O; const float* rope;
    DI void operator()(const f32x4 (&acc)[2][2][4][2], const Unit& u, int wr, int wc, int fr, int fq) const {
        const int rt = u.pm * BM; const bool islat = rt < ML;
        const int r0 = rt + wr * 64 + fr, cb = u.pn * BM + wc * 32 + 4 * fq, ax = wc & 1;
#pragma unroll
        for (int ai = 0; ai < 2; ++ai) {
            f32x4 csa[4], csb[4];
#pragma unroll
            for (int m = 0; m < 4; ++m) { const int row = r0 + ai * HALF + m * 16; const int t = row & 4095; const int pos = ax ? (t & 63) : (t >> 6);
                csa[m] = (f32x4){1.f, 0.f, 1.f, 0.f}; csb[m] = csa[m];
                if (islat) { csa[m] = *(const f32x4*)(rope + (pos * 16 + 4 * fq) * 2); csb[m] = *(const f32x4*)(rope + (pos * 16 + 4 * fq) * 2 + 4); } }
#pragma unroll
            for (int m = 0; m < 4; ++m) {
                const int row = r0 + ai * HALF + m * 16;
                f32x4 cs0 = csa[m], cs1 = csb[m];
                if (u.pn < 2) { cs0 *= 0.18033688011112042f; cs1 *= 0.18033688011112042f; }
#pragma unroll
                for (int bj = 0; bj < 2; ++bj) {
                    const f32x4 x1 = acc[ai][bj][m][0], x2 = acc[ai][bj][m][1];
                    const float c0 = cs0[0], s0 = cs0[1], c1 = cs0[2], s1 = cs0[3], c2 = cs1[0], s2 = cs1[1], c3 = cs1[2], s3 = cs1[3];
                    u32x2 o1, o2;
                    o1[0] = pk2(x1[0] * c0 - x2[0] * s0, x1[1] * c1 - x2[1] * s1); o1[1] = pk2(x1[2] * c2 - x2[2] * s2, x1[3] * c3 - x2[3] * s3);
                    o2[0] = pk2(x1[0] * s0 + x2[0] * c0, x1[1] * s1 + x2[1] * c1); o2[1] = pk2(x1[2] * s2 + x2[2] * c2, x1[3] * s3 + x2[3] * c3);
                    bf16_t* dst = O + (size_t)row * 1024 + cb + bj * HALF;
                    *(u32x2*)dst = o1; *(u32x2*)(dst + 16) = o2;
                }
            }
        }
    }
};
struct EpiStore {
    static constexpr bool PERM = true;
    bf16_t* O; size_t ldc; int qtiles;
    DI void operator()(const f32x4 (&acc)[2][2][4][2], const Unit& u, int wr, int wc, int fr, int fq) const {
        const int row0 = u.pm * BM + wr * 64 + fr; const size_t col0 = (size_t)u.pn * BM + wc * 32 + 8 * fq; const float qs = u.pn < qtiles ? 0.18033688011112042f : 1.f;
#pragma unroll
        for (int ai = 0; ai < 2; ++ai)
#pragma unroll
            for (int m = 0; m < 4; ++m) { bf16_t* rowp = O + (size_t)(row0 + ai * HALF + m * 16) * ldc + col0;
#pragma unroll
                for (int bj = 0; bj < 2; ++bj) { const f32x4 v0 = acc[ai][bj][m][0] * qs, v1 = acc[ai][bj][m][1] * qs; u32x4 o;
                    o[0] = pk2(v0[0], v0[1]); o[1] = pk2(v0[2], v0[3]); o[2] = pk2(v1[0], v1[1]); o[3] = pk2(v1[2], v1[3]);
                    *(u32x4*)(rowp + bj * HALF) = o; } }
    }
};
}

template <class Epi>
DI void run_gemm(unsigned char* shm, const bf16_t* A, const bf16_t* Bt, int M, int N, int K, const Epi& E, int rot = 0) {
    pg8::Gemm g{A, Bt, M, N, K, K};
    const int G = (int)gridDim.x;
    pg8::StaticOrder S; S.init(M, N, G, ((int)blockIdx.x + G - rot % G) % G);
    pg8::gemm_phase<Epi, pg8::StaticOrder>((LAS unsigned char*)shm, g, S, E);
    __syncthreads();
}
template <int NKC, class Epi>
DI void run_gemm_splitk(unsigned char* shm, const bf16_t* A, const bf16_t* Bt, int pm0, int npm, const Epi& E) {
    pg8::Gemm g{A, Bt, 0, 1024, 256, NKC * 256};
    pg8::SplitKOrder<NKC> S; S.init(pm0, npm, (int)gridDim.x, (int)blockIdx.x);
    pg8::gemm_phase<Epi, pg8::SplitKOrder<NKC>>((LAS unsigned char*)shm, g, S, E);
    __syncthreads();
}

DI void transpose_tile(float* tile  , const float* src, int N, bf16_t* dst, int K, int k0, int n0, int mode) {
    const int tid = tidx();
    {   const int kr = tid >> 6, nc = (tid & 63) * 4;
        f32x4 v[8];
#pragma unroll
        for (int q = 0; q < 8; ++q) v[q] = *(const f32x4*)(src + (size_t)(k0 + kr + 8 * q) * N + n0 + nc);
#pragma unroll
        for (int q = 0; q < 8; ++q) { float* t = tile + (kr + 8 * q) * 257 + nc; t[0] = v[q][0]; t[1] = v[q][1]; t[2] = v[q][2]; t[3] = v[q][3]; } }
    __syncthreads();
    {   const int nr = tid >> 1, kc = (tid & 1) * 32; const int n = n0 + nr;
        const int drow = mode == 0 ? n : ((n >> 7) * 256 + (n & 127) + (mode == 2 ? 128 : 0));
        bf16_t* d = dst + (size_t)drow * K + k0 + kc;
#pragma unroll
        for (int c = 0; c < 4; ++c) { u32x4 o;
#pragma unroll
            for (int i = 0; i < 4; ++i) o[i] = pk2(tile[(kc + 8 * c + 2 * i) * 257 + nr], tile[(kc + 8 * c + 2 * i + 1) * 257 + nr]);
            *(u32x4*)(d + 8 * c) = o; } }
    __syncthreads();
}

DI void prep_mod_unit(PP p, float* lds, int u) {
    const int tid = tidx(), layer = u / 36, cb = u % 36, w = tid >> 6, lane = tid & 63;
    float* s = lds;
    float* red = lds + 1024 * 12;
    for (int i = tid; i < 9 * 1024; i += 512) { const int bb = i >> 10, k = i & 1023; const float v = bb < 8 ? p->in[1][bb * 1024 + k] : p->in[3][k]; s[k * 12 + bb] = silu_f(v); }
    __syncthreads();
    const float* wp = p->in[4] + (size_t)layer * 1024 * 9216 + cb * 256 + lane * 4;
    f32x4 acc[9];
#pragma unroll
    for (int b = 0; b < 9; ++b) acc[b] = (f32x4){0.f, 0.f, 0.f, 0.f};
#pragma unroll 4
    for (int k = w; k < 1024; k += 8) { const f32x4 wv = *(const f32x4*)(wp + (size_t)k * 9216);
        const f32x4 s0 = *(const f32x4*)(s + k * 12), s1 = *(const f32x4*)(s + k * 12 + 4); const float s8 = s[k * 12 + 8];
        acc[0] += wv * s0[0]; acc[1] += wv * s0[1]; acc[2] += wv * s0[2]; acc[3] += wv * s0[3];
        acc[4] += wv * s1[0]; acc[5] += wv * s1[1]; acc[6] += wv * s1[2]; acc[7] += wv * s1[3]; acc[8] += wv * s8; }
#pragma unroll
    for (int b = 0; b < 9; ++b) *(f32x4*)(red + (w * 9 + b) * 256 + lane * 4) = acc[b];
    __syncthreads();
    float* mod = (float*)(p->ws + WS_MOD) + (size_t)layer * 9 * 9216;
    for (int i = tid; i < 9 * 256; i += 512) { const int b = i >> 8, c = i & 255; const int cg_ = cb * 256 + c; float a = p->in[5][layer * 9216 + cg_];
#pragma unroll
        for (int q = 0; q < 8; ++q) a += red[(q * 9 + b) * 256 + c];
        mod[(size_t)b * 9216 + cg_] = a; }
    __syncthreads();
}

DI void prep_filter_unit(PP p, float* lds, int n, int j0, bf16_t* out) {
    const int tid = tidx();
    float* zf = lds;
    float* hA = lds + 16 * 36;
    float* hB = hA + 16 * 64;
    float* w0s = hB + 16 * 64;
    float* w1s = w0s + 33 * 64;
    const float* w0 = p->in[16]; const float* b0 = p->in[17]; const float* w1 = p->in[18]; const float* b1 = p->in[19]; const float* fr = p->in[20]; const float* wo = p->in[21]; const float* hyb = p->in[22];
    for (int i = tid; i < 33 * 16; i += 512) *(f32x4*)(w0s + 4 * i) = *(const f32x4*)(w0 + 4 * i);
    for (int i = tid; i < 2048; i += 512) *(f32x4*)(w1s + 4 * i) = *(const f32x4*)(w1 + 4 * i);
    for (int i = tid; i < 16 * 33; i += 512) { const int jj = i / 33, e = i % 33; const int j = j0 + jj;
        const float t = (float)j / (float)(n - 1); const float wt = (float)j / (float)n;
        float v;
        if (e == 0) v = t; else { const int k = (e - 1) & 15; const float band = 1e-4f + (float)k * ((15.f - 1e-4f) / 15.f); v = e <= 16 ? cos_turns(band * wt) : -sin_turns(band * wt); }
        zf[jj * 36 + e] = v; }
    __syncthreads();
    for (int i = tid; i < 1024; i += 512) { const int jj = i >> 6, m = i & 63; float a = b0[m];
        for (int e = 0; e < 33; ++e) a += zf[jj * 36 + e] * w0s[e * 64 + m];
        hA[jj * 64 + m] = sin_rad(fr[m] * a); }
    __syncthreads();
    for (int i = tid; i < 1024; i += 512) { const int jj = i >> 6, m = i & 63; float a = b1[m];
        for (int e = 0; e < 64; ++e) a += hA[jj * 64 + e] * w1s[e * 64 + m];
        hB[jj * 64 + m] = sin_rad(fr[m] * a); }
    __syncthreads();
    for (int i = tid; i < 1024; i += 512) { const int jj = i >> 6, m = i & 63; float a = b1[64 + m];
        for (int e = 0; e < 64; ++e) a += hB[jj * 64 + e] * w1s[4096 + e * 64 + m];
        hA[jj * 64 + m] = sin_rad(fr[m] * a); }
    __syncthreads();
    const float dmin = -3.0701134573253945f, dmax = -15.350567286626972f;
    {   const int col0 = tid * 4;
        f32x4 acc[16];
#pragma unroll
        for (int jj = 0; jj < 16; ++jj) acc[jj] = (f32x4){0.f, 0.f, 0.f, 0.f};
#pragma unroll 1
        for (int k4 = 0; k4 < 16; ++k4) {
            const f32x4 wa = *(const f32x4*)(wo + (size_t)(4 * k4 + 0) * 2048 + col0), wb = *(const f32x4*)(wo + (size_t)(4 * k4 + 1) * 2048 + col0),
                        wc_ = *(const f32x4*)(wo + (size_t)(4 * k4 + 2) * 2048 + col0), wd = *(const f32x4*)(wo + (size_t)(4 * k4 + 3) * 2048 + col0);
#pragma unroll
            for (int jj = 0; jj < 16; ++jj) { const f32x4 h = *(const f32x4*)(hA + jj * 64 + 4 * k4); acc[jj] += wa * h[0] + wb * h[1] + wc_ * h[2] + wd * h[3]; }
        }
#pragma unroll
        for (int q = 0; q < 4; ++q) {
            const int col = col0 + q; const int c = col & 511, od = col >> 9;
            const float delta = fabsf(dmin + (dmax - dmin) * ((float)c / 511.f));
            float v[16];
#pragma unroll
            for (int jj = 0; jj < 16; ++jj) { const int j = j0 + jj; const float t = (float)j / (float)(n - 1); v[jj] = acc[jj][q] * __expf(-t * delta); }
            if (j0 == 0 && (od & 1) == 0) v[0] += hyb[(od >> 1) * 512 + c];
            u32x4 o0, o1;
#pragma unroll
            for (int i = 0; i < 4; ++i) { o0[i] = pk2(v[2 * i], v[2 * i + 1]); o1[i] = pk2(v[8 + 2 * i], v[8 + 2 * i + 1]); }
            bf16_t* dst = out + (size_t)col * n + j0;
            *(u32x4*)dst = o0; *(u32x4*)(dst + 8) = o1;
        }
    }
    __syncthreads();
}

DI void norm_rows(PP p, int layer, int k, bool copy, int row_begin, int nrows, int gw, int nw);
DI void phase_prep(PP p, unsigned char* shm, int stage) {
    float* lds = (float*)shm;
    constexpr int NU_MOD = 72, NU_FL = 256, NU_FC = 16, NU_ROPE = 1, NU_TR = 2624, NU_S0 = NU_MOD + NU_FL + NU_FC + NU_ROPE, NU_NORM = MT / 256;
    const int ubeg = stage == 0 ? 0 : NU_S0 - NU_NORM, uend = stage == 0 ? NU_S0 : NU_S0 + NU_TR;
    for (int u0 = ubeg + (int)blockIdx.x; u0 < uend; u0 += gridDim.x) {
        int u = u0;
        if (stage == 1 && u < NU_S0) { norm_rows(p, 0, 0, true, (u - ubeg) * 256, (u - ubeg) * 256 + 256, tidx() >> 6, 8); continue; }
        if (u < NU_MOD) { prep_mod_unit(p, lds, u); continue; }
        u -= NU_MOD;
        if (u < NU_FL) { prep_filter_unit(p, lds, 4096, u * 16, (bf16_t*)(p->ws + WS_HL)); continue; }
        u -= NU_FL;
        if (u < NU_FC) { prep_filter_unit(p, lds, 256, u * 16, (bf16_t*)(p->ws + WS_HC)); continue; }
        u -= NU_FC;
        if (u < NU_ROPE) { float* rope = (float*)(p->ws + WS_ROPE);
            for (int i = tidx(); i < 1024; i += 512) { const int pos = i >> 4, f = i & 15; const float inv = exp2f(-(float)f * (13.287712379549449f / 16.f)); const float a = (float)pos * inv * 0.15915494309189535f; rope[2 * i] = cos_turns(a); rope[2 * i + 1] = sin_turns(a); }
            continue; }
        u -= NU_ROPE;
        const float* src; bf16_t* dst; int K, N, mode, tile;
        if (u < 2112) { const int job = u / 176; tile = u % 176; const int lf = job / 3, kind = job % 3;
            if (kind < 2) { src = p->in[7 + kind] + (size_t)lf * 1024 * 2816; K = 1024; N = 2816; dst = (bf16_t*)(p->ws + WS_W13T) + (size_t)lf * 5632 * 1024; mode = 1 + kind; }
            else { src = p->in[9] + (size_t)lf * 2816 * 1024; K = 2816; N = 1024; dst = (bf16_t*)(p->ws + WS_W2T) + (size_t)lf * 1024 * 2816; mode = 0; } }
        else { u -= 2112;
            if (u < 384) { const int job = u / 192; tile = u % 192; src = p->in[job ? 23 : 10]; K = 1024; N = 3072; dst = (bf16_t*)(p->ws + (job ? WS_NAIN : WS_ABIN)); mode = 0; }
            else { u -= 384; const int job = u / 64; tile = u % 64; src = p->in[job ? 24 : 11]; K = 1024; N = 1024; dst = (bf16_t*)(p->ws + (job ? WS_NAOUT : WS_ABOUT)); mode = 0; } }
        const int ntn = N / 256; const int k0 = (tile / ntn) * 64, n0 = (tile % ntn) * 256;
        transpose_tile(lds, src, N, dst, K, k0, n0, mode);
    }
}

DI void norm_rows(PP p, int layer, int k, bool copy, int row_begin, int nrows, int gw, int nw) {
    const int lane = tidx() & 63;
    const float* gn = p->in[6] + (size_t)(layer * 3 + k) * D;
    const float* mod = (const float*)(p->ws + WS_MOD) + (size_t)layer * 9 * 9216;
    bf16_t* hn = (bf16_t*)(p->ws + WS_HN);
    bf16_t* xs = (bf16_t*)(p->ws + WS_XS);
    for (int row0 = row_begin + gw * 4; row0 < nrows; row0 += nw * 4) {
        const bool islat = row0 < ML; const int bb = islat ? (row0 >> 12) : 8;
        float x[4][2][8]; float ss[4];
        if (copy) { const float* src = islat ? p->in[0] + (size_t)row0 * D : p->in[2] + (size_t)(row0 - ML) * D;
#pragma unroll
            for (int j = 0; j < 4; ++j)
#pragma unroll
                for (int q = 0; q < 2; ++q) { const f32x4 a = *(const f32x4*)(src + (size_t)j * D + q * 512 + lane * 8), c = *(const f32x4*)(src + (size_t)j * D + q * 512 + lane * 8 + 4);
                    for (int i = 0; i < 4; ++i) { x[j][q][i] = a[i]; x[j][q][4 + i] = c[i]; } }
        } else { const bf16_t* src = xs + (size_t)row0 * D;
#pragma unroll
            for (int j = 0; j < 4; ++j)
#pragma unroll
                for (int q = 0; q < 2; ++q) { const u32x4 v = *(const u32x4*)(src + (size_t)j * D + q * 512 + lane * 8);
                    for (int i = 0; i < 4; ++i) { x[j][q][2 * i] = bflo(v[i]); x[j][q][2 * i + 1] = bfhi(v[i]); } }
        }
        const float* sh = mod + (size_t)bb * 9216 + (3 * k) * D; const float* sc = sh + D;
        float gg[2][8], s0[2][8];
#pragma unroll
        for (int q = 0; q < 2; ++q)
#pragma unroll
            for (int hh = 0; hh < 2; ++hh) { const int c = q * 512 + lane * 8 + 4 * hh; const f32x4 g = *(const f32x4*)(gn + c), s1 = *(const f32x4*)(sc + c), sv = *(const f32x4*)(sh + c);
                for (int i = 0; i < 4; ++i) { gg[q][4 * hh + i] = g[i] * (1.f + s1[i]); s0[q][4 * hh + i] = sv[i]; } }
#pragma unroll
        for (int j = 0; j < 4; ++j) { float a = 0.f;
#pragma unroll
            for (int q = 0; q < 2; ++q)
#pragma unroll
                for (int i = 0; i < 8; ++i) a += x[j][q][i] * x[j][q][i];
            ss[j] = rsqrtf(wave_sum(a, lane) * (1.f / D) + 1e-6f); }
        if (copy) {
#pragma unroll
            for (int j = 0; j < 4; ++j)
#pragma unroll
                for (int q = 0; q < 2; ++q) { u32x4 o; for (int i = 0; i < 4; ++i) o[i] = pk2(x[j][q][2 * i], x[j][q][2 * i + 1]);
                    *(u32x4*)(xs + (size_t)(row0 + j) * D + q * 512 + lane * 8) = o; } }
#pragma unroll
        for (int j = 0; j < 4; ++j)
#pragma unroll
            for (int q = 0; q < 2; ++q) { u32x4 o;
                for (int i = 0; i < 4; ++i) o[i] = pk2(x[j][q][2 * i] * ss[j] * gg[q][2 * i] + s0[q][2 * i], x[j][q][2 * i + 1] * ss[j] * gg[q][2 * i + 1] + s0[q][2 * i + 1]);
                *(u32x4*)(hn + (size_t)(row0 + j) * D + q * 512 + lane * 8) = o; }
    }
}
DI void phase_norm(PP p, int layer, int k, int nrows, bool copy) { norm_rows(p, layer, k, copy, 0, nrows, (int)blockIdx.x * 8 + (tidx() >> 6), (int)gridDim.x * 8); }
DI void phase_final_norm(PP p) {
    const int lane = tidx() & 63, gw = blockIdx.x * 8 + (tidx() >> 6), nw = gridDim.x * 8;
    const float* gn = p->in[26];
    const bf16_t* xs = (const bf16_t*)(p->ws + WS_XS);
    for (int row0 = gw * 4; row0 < ML; row0 += nw * 4) {
        float x[4][2][8];
#pragma unroll
        for (int j = 0; j < 4; ++j)
#pragma unroll
            for (int q = 0; q < 2; ++q) { const u32x4 v = *(const u32x4*)(xs + (size_t)(row0 + j) * D + q * 512 + lane * 8);
                for (int i = 0; i < 4; ++i) { x[j][q][2 * i] = bflo(v[i]); x[j][q][2 * i + 1] = bfhi(v[i]); } }
        float g[2][8];
#pragma unroll
        for (int q = 0; q < 2; ++q)
#pragma unroll
            for (int hh = 0; hh < 2; ++hh) { const f32x4 gv = *(const f32x4*)(gn + q * 512 + lane * 8 + 4 * hh); for (int i = 0; i < 4; ++i) g[q][4 * hh + i] = gv[i]; }
#pragma unroll
        for (int j = 0; j < 4; ++j) { float a = 0.f;
#pragma unroll
            for (int q = 0; q < 2; ++q)
#pragma unroll
                for (int i = 0; i < 8; ++i) a += x[j][q][i] * x[j][q][i];
            const float rstd = rsqrtf(wave_sum(a, lane) * (1.f / D) + 1e-6f);
            float* dst = p->out + (size_t)(row0 + j) * D;
#pragma unroll
            for (int q = 0; q < 2; ++q)
#pragma unroll
                for (int hh = 0; hh < 2; ++hh) { f32x4 y; for (int i = 0; i < 4; ++i) y[i] = x[j][q][4 * hh + i] * rstd * g[q][4 * hh + i];
                    *(f32x4*)(dst + q * 512 + lane * 8 + 4 * hh) = y; } }
    }
}

#define MFMA32(a, b, c) __builtin_amdgcn_mfma_f32_32x32x16_bf16((a), (b), (c), 0, 0, 0)
template <int DVT> struct FA { f32x16 o[DVT]; float m, l; };

template <int DVT, bool NAB>
DI void fa_tile(FA<DVT>& st, const bf16x8 (&qf)[4], const bf16x8 (&kf)[4], const bf16x8 (&vf)[DVT][2], float cscale,
                const float* rpbrow  , int idx0, int lo) {
    f32x16 s;
#pragma unroll
    for (int r = 0; r < 16; ++r) s[r] = 0.f;
#pragma unroll
    for (int kk = 0; kk < 4; ++kk) s = MFMA32(kf[kk], qf[kk], s);
    float sv[16]; float mx = -1e30f;
#pragma unroll
    for (int r = 0; r < 16; ++r) {
        float v = s[r] * cscale;
        if (NAB) { const int idx = idx0 + 16 * (r >> 3) + (r & 7); const bool valid = (unsigned)(idx - lo) < 16u; v = valid ? v + rpbrow[valid ? idx : 0] : -1e30f; }
        sv[r] = v; mx = fmaxf(mx, v);
    }
    mx = fmaxf(mx, __shfl_xor(mx, 32));
    const float mnew = fmaxf(st.m, mx);
    if (__any(mnew > st.m)) {
        const float alpha = __builtin_amdgcn_exp2f(st.m - mnew);
        st.l *= alpha;
#pragma unroll
        for (int dt = 0; dt < DVT; ++dt)
#pragma unroll
            for (int r = 0; r < 16; ++r) st.o[dt][r] *= alpha;
        st.m = mnew;
    }
    float ps = 0.f;
#pragma unroll
    for (int r = 0; r < 16; ++r) { sv[r] = __builtin_amdgcn_exp2f(sv[r] - st.m); ps += sv[r]; }
    st.l += ps;
    bf16x8 pf[2];
#pragma unroll
    for (int j = 0; j < 2; ++j) { u32x4 t; t[0] = pk2(sv[8 * j], sv[8 * j + 1]); t[1] = pk2(sv[8 * j + 2], sv[8 * j + 3]); t[2] = pk2(sv[8 * j + 4], sv[8 * j + 5]); t[3] = pk2(sv[8 * j + 6], sv[8 * j + 7]); pf[j] = __builtin_bit_cast(bf16x8, t); }
#pragma unroll
    for (int dt = 0; dt < DVT; ++dt)
#pragma unroll
        for (int j = 0; j < 2; ++j) st.o[dt] = MFMA32(vf[dt][j], pf[j], st.o[dt]);
}

constexpr int DA_KS = 272, DA_VS = 144;
constexpr int DA_KB = 64 * DA_KS, DA_VB = 128 * DA_VS, DA_STAGE = DA_KB + DA_VB, DA_Q = 2 * DA_STAGE, DA_QB = 256 * DA_KS;
static_assert(DA_Q + DA_QB <= LDS_XST, "lds");
template <int VAR>
DI void diffattn_unit(PP p, unsigned char* shm, int b, int h, int qtok0, int nkt) {
    LAS unsigned char* lds = (LAS unsigned char*)shm;
    const int tid = tidx(), w = tid >> 6, lane = tid & 63, i = lane & 31, g = lane >> 5, map = w >> 2, qs = w & 3;
    const bf16_t* QK = (const bf16_t*)(p->ws + WS_BIG);
    const bf16_t* VT = QK + (size_t)MT * 1024;
    const int kp = kperm(i);
    const unsigned gko = (unsigned)((tid >> 4) * 1024 + 512 + h * 128 + 8 * (tid & 15));
    const unsigned gvo = (unsigned)((h * 128 + (tid >> 3)) * MT + 8 * (tid & 7));
    const int lkw = (tid >> 4) * DA_KS + (tid & 15) * 16, lvw = DA_KB + (tid >> 3) * DA_VS + (tid & 7) * 16;
    const int ctok = ML + b * NCTX, ltok = b * SEQ;
#pragma unroll
    for (int qq = 0; qq < 8; ++qq) { const int c = tid + 512 * qq; const int row = c >> 4, ch = c & 15;
        const u32x4 v = *(const u32x4*)(QK + (size_t)(qtok0 + row) * 1024 + h * 128 + 8 * ch);
        *(LAS u32x4*)(lds + DA_Q + row * DA_KS + ch * 16) = v; }
    u32x4 rr_[2];
#define DA_TOK(kt_) ((kt_) < 4 ? ctok + 64 * (kt_) : ltok + 64 * ((kt_) - 4))
#define DA_LOADK(kt_) do { const unsigned tok0 = (unsigned)DA_TOK(kt_); rr_[0] = *(const u32x4*)(QK + (gko + tok0 * 1024u)); rr_[1] = *(const u32x4*)(QK + (gko + (tok0 + 32u) * 1024u)); } while (0)
#define DA_LOADV(kt_) do { const unsigned tok0 = (unsigned)DA_TOK(kt_); rr_[0] = *(const u32x4*)(VT + (gvo + tok0)); rr_[1] = *(const u32x4*)(VT + (gvo + 64u * MT + tok0)); } while (0)
#define DA_STOREK(st_) do { LAS unsigned char* _sn = lds + (st_) * DA_STAGE; *(LAS u32x4*)(_sn + lkw) = rr_[0]; *(LAS u32x4*)(_sn + lkw + 32 * DA_KS) = rr_[1]; } while (0)
#define DA_STOREV(st_) do { LAS unsigned char* _sn = lds + (st_) * DA_STAGE; *(LAS u32x4*)(_sn + lvw) = rr_[0]; *(LAS u32x4*)(_sn + lvw + 64 * DA_VS) = rr_[1]; } while (0)
    DA_LOADK(0); DA_STOREK(0); DA_LOADV(0); DA_STOREV(0);
    __syncthreads();
    const int aK = kp * DA_KS + (map * 64 + 8 * g) * 2;
    const int aV = DA_KB + kp * DA_VS + 8 * g * 2;
    const int aQ = DA_Q + (64 * qs + i) * DA_KS + (map * 64 + 8 * g) * 2;
    f32x16 o[2][4];
#pragma unroll
    for (int qt = 0; qt < 2; ++qt)
#pragma unroll
        for (int dt = 0; dt < 4; ++dt)
#pragma unroll
            for (int r = 0; r < 16; ++r) o[qt][dt][r] = 0.f;
    float mref[2], lsum[2] = {0.f, 0.f}, pmp[2] = {0.f, 0.f};
    {
        float mx[2] = {-1e30f, -1e30f};
#pragma unroll
        for (int sub = 0; sub < 2; ++sub) { f32x16 S[2];
#pragma unroll
            for (int qt = 0; qt < 2; ++qt)
#pragma unroll
                for (int r = 0; r < 16; ++r) S[qt][r] = 0.f;
#pragma unroll
            for (int kk = 0; kk < 4; ++kk) { const bf16x8 kf = *(LAS const bf16x8*)(lds + aK + sub * 32 * DA_KS + 32 * kk);
#pragma unroll
                for (int qt = 0; qt < 2; ++qt) { const bf16x8 qf = *(LAS const bf16x8*)(lds + aQ + qt * 32 * DA_KS + 32 * kk); S[qt] = MFMA32(kf, qf, S[qt]); } }
#pragma unroll
            for (int qt = 0; qt < 2; ++qt)
#pragma unroll
                for (int r = 0; r < 16; ++r) mx[qt] = fmaxf(mx[qt], S[qt][r]); }
#pragma unroll
        for (int qt = 0; qt < 2; ++qt) mref[qt] = fmaxf(mx[qt], shx(mx[qt], lane, 32)); }
    for (int kt = 0; kt < nkt; ++kt) {
        const bool more = kt + 1 < nkt;
        if (__any(fmaxf(pmp[0], pmp[1]) > 32768.f)) {
#pragma unroll
            for (int qt = 0; qt < 2; ++qt) { const float pm = fmaxf(pmp[qt], shx(pmp[qt], lane, 32));
                const float kk_ = pm > 32768.f ? floorf(__builtin_amdgcn_logf(pm)) : 0.f; const float f_ = __builtin_amdgcn_exp2f(-kk_);
#pragma unroll
                for (int dt = 0; dt < 4; ++dt)
#pragma unroll
                    for (int r = 0; r < 16; ++r) o[qt][dt][r] *= f_;
                lsum[qt] *= f_; mref[qt] += kk_; } }
        pmp[0] = 0.f; pmp[1] = 0.f;
        LAS const unsigned char* sb = lds + (kt & 1) * DA_STAGE;
#pragma unroll
        for (int sub = 0; sub < 2; ++sub) {
            if (more) { if (sub == 0) DA_LOADK(kt + 1); else DA_LOADV(kt + 1); }
            f32x16 S[2];
#pragma unroll
            for (int qt = 0; qt < 2; ++qt)
#pragma unroll
                for (int r = 0; r < 16; ++r) S[qt][r] = 0.f;
#pragma unroll
            for (int kk = 0; kk < 4; ++kk) { const bf16x8 kf = *(LAS const bf16x8*)(sb + aK + sub * 32 * DA_KS + 32 * kk);
#pragma unroll
                for (int qt = 0; qt < 2; ++qt) { const bf16x8 qf = *(LAS const bf16x8*)(lds + aQ + qt * 32 * DA_KS + 32 * kk); S[qt] = MFMA32(kf, qf, S[qt]); }
                if (kk != 3) __builtin_amdgcn_sched_barrier(0); }
            bf16x8 pf[2][2];
#pragma unroll
            for (int qt = 0; qt < 2; ++qt) {
#pragma unroll
                for (int r = 0; r < 16; ++r) { S[qt][r] = __builtin_amdgcn_exp2f(S[qt][r] - mref[qt]); lsum[qt] += S[qt][r]; }
#pragma unroll
                for (int r = 0; r < 16; r += 2) pmp[qt] = fmaxf(fmaxf(pmp[qt], S[qt][r]), S[qt][r + 1]);
#pragma unroll
                for (int j = 0; j < 2; ++j) { u32x4 t; t[0] = pk2(S[qt][8 * j], S[qt][8 * j + 1]); t[1] = pk2(S[qt][8 * j + 2], S[qt][8 * j + 3]); t[2] = pk2(S[qt][8 * j + 4], S[qt][8 * j + 5]); t[3] = pk2(S[qt][8 * j + 6], S[qt][8 * j + 7]); pf[qt][j] = __builtin_bit_cast(bf16x8, t); }
            }
#pragma unroll
            for (int dt = 0; dt < 4; ++dt)
#pragma unroll
                for (int j = 0; j < 2; ++j) { const bf16x8 vf = *(LAS const bf16x8*)(sb + aV + dt * 32 * DA_VS + sub * 64 + 32 * j);
                    o[0][dt] = MFMA32(vf, pf[0][j], o[0][dt]); o[1][dt] = MFMA32(vf, pf[1][j], o[1][dt]);
                    if (j == 1) __builtin_amdgcn_sched_barrier(0); }
            if (more) { if (sub == 0) DA_STOREK((kt + 1) & 1); else DA_STOREV((kt + 1) & 1); }
        }
        __syncthreads();
    }
#undef DA_TOK
#undef DA_LOADK
#undef DA_LOADV
#undef DA_STOREK
#undef DA_STOREV
    const float* lp = p->in[12];
    float la = wave_sum(lp[lane] * lp[64 + lane], lane), lb = wave_sum(lp[128 + lane] * lp[192 + lane], lane);
    const float lam = __expf(la) - __expf(lb) + 0.2f;
    float* ob = (float*)shm;
    float inv[2];
#pragma unroll
    for (int qt = 0; qt < 2; ++qt) inv[qt] = 1.f / (lsum[qt] + shx(lsum[qt], lane, 32));
    if (map == 1) {
#pragma unroll
        for (int qt = 0; qt < 2; ++qt)
#pragma unroll
            for (int dt = 0; dt < 4; ++dt)
#pragma unroll
                for (int r = 0; r < 16; ++r) ob[(32 * dt + 16 * (r >> 3) + 8 * g + (r & 7)) * 256 + 64 * qs + 32 * qt + i] = o[qt][dt][r] * inv[qt];
    }
    __syncthreads();
    if (map == 0) {
        const float* sw = p->in[13];
#pragma unroll
        for (int qt = 0; qt < 2; ++qt) {
            float ss = 0.f;
#pragma unroll
            for (int dt = 0; dt < 4; ++dt) {
#pragma unroll
                for (int r = 0; r < 16; ++r) { const float v = o[qt][dt][r] * inv[qt] - lam * ob[(32 * dt + 16 * (r >> 3) + 8 * g + (r & 7)) * 256 + 64 * qs + 32 * qt + i]; o[qt][dt][r] = v; ss += v * v; }
                __builtin_amdgcn_sched_barrier(0); }
            ss += shx(ss, lane, 32);
            const float rstd = rsqrtf(ss * (1.f / 128.f) + 1e-6f) * 0.8f;
            bf16_t* dst = (bf16_t*)(p->ws + (VAR ? WS_END : WS_HN)) + (size_t)(qtok0 + 64 * qs + 32 * qt + i) * 1024 + h * 128;
#pragma unroll
            for (int dt = 0; dt < 4; ++dt)
#pragma unroll
                for (int rr = 0; rr < 2; ++rr) { const int dv = 32 * dt + 16 * rr + 8 * g; u32x4 ov;
#pragma unroll
                    for (int e = 0; e < 4; ++e) ov[e] = pk2(o[qt][dt][8 * rr + 2 * e] * rstd * sw[dv + 2 * e], o[qt][dt][8 * rr + 2 * e + 1] * rstd * sw[dv + 2 * e + 1]);
                    *(u32x4*)(dst + dv) = ov; }
        }
    }
    __syncthreads();
}

constexpr int VP = 4616, VPAD = 256;
constexpr int HY_G0 = 8 * VP * 2;
constexpr int GLEN = 8192 + 64;
constexpr int HY_G1 = HY_G0 + GLEN * 2 + 64;
static_assert(HY_G1 + GLEN * 2 <= LDS_BYTES, "lds");

DI void shortconv8(const bf16_t* row, int t, int n, float w0, float w1, float w2, float bias, float (&o)[8]) {
    const u32x4 c = *(const u32x4*)(row + t);
    float x[10];
    x[0] = t > 0 ? bf2f(row[t - 1]) : 0.f; x[9] = t + 8 < n ? bf2f(row[t + 8]) : 0.f;
#pragma unroll
    for (int e = 0; e < 4; ++e) { x[1 + 2 * e] = bflo(c[e]); x[2 + 2 * e] = bfhi(c[e]); }
#pragma unroll
    for (int e = 0; e < 8; ++e) o[e] = w0 * x[e] + w1 * x[e + 1] + w2 * x[e + 2] + bias;
}

DI void hy_fill_g(LAS unsigned char* lds, const bf16_t* hf, const bf16_t* hb) {
    const int t = tidx();
    const u32x4 F = *(const u32x4*)(hf + 8 * t), B = *(const u32x4*)(hb + 8 * t);
    const unsigned fn = t < 511 ? hf[8 * t + 8] : 0u, bn = t < 511 ? hb[8 * t + 8] : 0u, f0 = hf[0];
    u32x4 g1f, g0f, g0b, g1b;
    g1f[0] = (F[3] >> 16) | (F[3] << 16); g1f[1] = (F[2] >> 16) | (F[2] << 16); g1f[2] = (F[1] >> 16) | (F[1] << 16); g1f[3] = (F[0] >> 16) | (F[0] << 16);
    g0f[0] = fn | (F[3] & 0xffff0000u); g0f[1] = (F[3] & 0xffffu) | (F[2] & 0xffff0000u); g0f[2] = (F[2] & 0xffffu) | (F[1] & 0xffff0000u); g0f[3] = (F[1] & 0xffffu) | (F[0] & 0xffff0000u);
    g0b = B; if (t == 0) g0b[0] = (B[0] & 0xffff0000u) | f0;
    g1b[0] = (B[0] >> 16) | (B[1] << 16); g1b[1] = (B[1] >> 16) | (B[2] << 16); g1b[2] = (B[2] >> 16) | (B[3] << 16); g1b[3] = (B[3] >> 16) | (bn << 16);
    *(LAS u32x4*)(lds + HY_G1 + 2 * (4088 - 8 * t)) = g1f; *(LAS u32x4*)(lds + HY_G0 + 2 * (4088 - 8 * t)) = g0f;
    *(LAS u32x4*)(lds + HY_G0 + 2 * (4096 + 8 * t)) = g0b; *(LAS u32x4*)(lds + HY_G1 + 2 * (4096 + 8 * t)) = g1b;
    if (t < 16) *(LAS u32x4*)(lds + (t < 8 ? HY_G0 : HY_G1) + 2 * (8192 + 8 * (t & 7))) = zero4();
}

DI void hy_conv(LAS const unsigned char* lds, int w, int lane, f32x16 (&acc)[2][2]) {
    const int i = lane & 31, g = lane >> 5, pi = kperm(i);
#pragma unroll
    for (int mt = 0; mt < 2; ++mt)
#pragma unroll
        for (int nt = 0; nt < 2; ++nt)
#pragma unroll
            for (int r = 0; r < 16; ++r) acc[mt][nt][r] = 0.f;
    const int abase = ((pi & 1) ? HY_G1 : HY_G0) + 2 * (4096 - pi + 8 * g - (pi & 1));
    const int bbase = ((i & 7) * VP + VPAD + 64 * (8 * w + (i >> 3)) + 8 * g) * 2;
    for (int dl = 8 * w - 63; dl <= 8 * w + 7; ++dl) {
        bf16x8 af[2][4];
#pragma unroll
        for (int mt = 0; mt < 2; ++mt)
#pragma unroll
            for (int kk = 0; kk < 4; ++kk) {
                LAS const unsigned* ap = (LAS const unsigned*)(lds + abase - 128 * dl - 64 * mt + 32 * kk);
                u32x4 t; t[0] = ap[0]; t[1] = ap[1]; t[2] = ap[2]; t[3] = ap[3];
                af[mt][kk] = __builtin_bit_cast(bf16x8, t);
            }
#pragma unroll
        for (int nt = 0; nt < 2; ++nt) {
            if (dl >= 8 * w + 4 * nt - 63 && dl <= 8 * w + 4 * nt + 3) {
                bf16x8 bfr[4];
#pragma unroll
                for (int kk = 0; kk < 4; ++kk) bfr[kk] = *(LAS const bf16x8*)(lds + bbase + 512 * nt - 128 * dl + 32 * kk);
#pragma unroll
                for (int mt = 0; mt < 2; ++mt)
#pragma unroll
                    for (int kk = 0; kk < 4; ++kk) acc[mt][nt] = MFMA32(af[mt][kk], bfr[kk], acc[mt][nt]);
            }
        }
    }
}

DI void hyena_unit(PP p, unsigned char* shm, int c) {
    LAS unsigned char* lds = (LAS unsigned char*)shm;
    const int tid = tidx(), w = tid >> 6, lane = tid & 63, i = lane & 31, g = lane >> 5;
    const bf16_t* UT = (const bf16_t*)(p->ws + WS_BIG) + (size_t)MT * 1024 + (size_t)512 * MT;
    const float* cw = p->in[14]; const float* cbias = p->in[15];
    const bf16_t* HL = (const bf16_t*)(p->ws + WS_HL);
    for (int q = tid; q < 8 * 64; q += 512) { const int b = q >> 6, e = q & 63; const int off = (e < 32 ? e * 8 : 4096 + VPAD + (e - 32) * 8);
        *(LAS u32x4*)(lds + (b * VP + off) * 2) = zero4(); }
    {   const int ch = 1024 + c; const float w0 = cw[ch], w1 = cw[1536 + ch], w2 = cw[3072 + ch], bs = cbias[ch];
#pragma unroll
        for (int qq = 0; qq < 8; ++qq) { const int q = tid + 512 * qq; const int b = q >> 9, t = (q & 511) * 8; float o[8];
            shortconv8(UT + (size_t)ch * MT + b * SEQ, t, SEQ, w0, w1, w2, bs, o);
            u32x4 v; for (int e = 0; e < 4; ++e) v[e] = pk2(o[2 * e], o[2 * e + 1]);
            *(LAS u32x4*)(lds + (b * VP + VPAD + t) * 2) = v; } }
    hy_fill_g(lds, HL + (size_t)(0 * 512 + c) * 4096, HL + (size_t)(1 * 512 + c) * 4096);
    __syncthreads();
    f32x16 acc[2][2];
    hy_conv(lds, w, lane, acc);
    __syncthreads();
    {   const int ch = c; const float w0 = cw[ch], w1 = cw[1536 + ch], w2 = cw[3072 + ch], bs = cbias[ch]; const int b = i & 7;
#pragma unroll
        for (int mt = 0; mt < 2; ++mt)
#pragma unroll
            for (int nt = 0; nt < 2; ++nt)
#pragma unroll
                for (int rr = 0; rr < 2; ++rr) { const int t = 64 * (8 * w + 4 * nt + (i >> 3)) + 32 * mt + 16 * rr + 8 * g; float o[8];
                    shortconv8(UT + (size_t)ch * MT + b * SEQ, t, SEQ, w0, w1, w2, bs, o);
                    u32x4 v; for (int e = 0; e < 4; ++e) v[e] = pk2(o[2 * e] * acc[mt][nt][8 * rr + 2 * e], o[2 * e + 1] * acc[mt][nt][8 * rr + 2 * e + 1]);
                    *(LAS u32x4*)(lds + (b * VP + VPAD + t) * 2) = v; } }
    hy_fill_g(lds, HL + (size_t)(2 * 512 + c) * 4096, HL + (size_t)(3 * 512 + c) * 4096);
    __syncthreads();
    hy_conv(lds, w, lane, acc);
    {   const int ch = 512 + c; const float w0 = cw[ch], w1 = cw[1536 + ch], w2 = cw[3072 + ch], bs = cbias[ch]; const int b = i & 7;
        bf16_t* BT = (bf16_t*)(p->ws + WS_BT) + (size_t)c * MT;
#pragma unroll
        for (int mt = 0; mt < 2; ++mt)
#pragma unroll
            for (int nt = 0; nt < 2; ++nt)
#pragma unroll
                for (int rr = 0; rr < 2; ++rr) { const int t = 64 * (8 * w + 4 * nt + (i >> 3)) + 32 * mt + 16 * rr + 8 * g; float o[8];
                    shortconv8(UT + (size_t)ch * MT + b * SEQ, t, SEQ, w0, w1, w2, bs, o);
                    u32x4 v; for (int e = 0; e < 4; ++e) v[e] = pk2(o[2 * e] * acc[mt][nt][8 * rr + 2 * e], o[2 * e + 1] * acc[mt][nt][8 * rr + 2 * e + 1]);
                    *(u32x4*)(BT + b * SEQ + t) = v; } }
    __syncthreads();
}

DI void hyena_ctx_unit(PP p, unsigned char* shm, int c) {
    float* lds = (float*)shm;
    float* vv = lds; float* x1 = lds + 2048; float* x2 = lds + 4096; float* zz = lds + 6144; float* g1 = lds + 8192; float* g2 = g1 + 512;
    const int tid = tidx();
    const bf16_t* UT = (const bf16_t*)(p->ws + WS_BIG) + (size_t)MT * 1024 + (size_t)512 * MT;
    const float* cw = p->in[14]; const float* cbias = p->in[15];
    const bf16_t* HC = (const bf16_t*)(p->ws + WS_HC);
    for (int q = tid; q < 3 * 2048; q += 512) { const int part = q >> 11, r = q & 2047, b = r >> 8, t = r & 255; const int ch = part * 512 + c;
        const bf16_t* row = UT + (size_t)ch * MT + ML + b * NCTX;
        const float xm = t > 0 ? bf2f(row[t - 1]) : 0.f, x0 = bf2f(row[t]), xp = t < 255 ? bf2f(row[t + 1]) : 0.f;
        const float v = cw[ch] * xm + cw[1536 + ch] * x0 + cw[3072 + ch] * xp + cbias[ch];
        (part == 0 ? x1 : part == 1 ? x2 : vv)[r] = v; }
    for (int q = tid; q < 1024; q += 512) { const int o = q >> 9, e = q & 511; const int d = e - 256;
        float v = 0.f;
        if (d >= 0 && d < 256) v = bf2f(HC[(size_t)((o * 2 + 0) * 512 + c) * 256 + d]); else if (d < 0 && d > -256) v = bf2f(HC[(size_t)((o * 2 + 1) * 512 + c) * 256 - d]);
        (o ? g2 : g1)[e] = v; }
    __syncthreads();
    for (int q = tid; q < 2048; q += 512) { const int b = q >> 8, t = q & 255; float a = 0.f;
        for (int s = 0; s < 256; ++s) a += g1[t - s + 256] * vv[b * 256 + s];
        zz[q] = x1[q] * a; }
    __syncthreads();
    bf16_t* BT = (bf16_t*)(p->ws + WS_BT) + (size_t)c * MT + ML;
    for (int q = tid; q < 2048; q += 512) { const int b = q >> 8, t = q & 255; float a = 0.f;
        for (int s = 0; s < 256; ++s) a += g2[t - s + 256] * zz[b * 256 + s];
        BT[q] = f2bf(x2[q] * a); }
    __syncthreads();
}

template <int VAR>
DI void phase_ab_mix(PP p, unsigned char* shm, int mask) {
    constexpr int NU_A = 512, NU_H = 512, NU_AC = 32, NU_HC = 512;
    for (int u0 = blockIdx.x; u0 < NU_A + NU_H + NU_AC + NU_HC; u0 += gridDim.x) {
        int u = u0;
        if (!(mask & 1) && u < NU_A) continue;
        if (!(mask & 2) && u >= NU_A && u < NU_A + NU_H) continue;
        if (!(mask & 4) && u >= NU_A + NU_H) continue;
        if (u < NU_A) { const int rnd = u >> 8, wg = u & 255; const int pair = rnd * 16 + (wg & 7) * 2 + (wg >> 7), qb = (wg >> 3) & 15;
            const int b = pair >> 2, h = pair & 3; diffattn_unit<VAR>(p, shm, b, h, b * SEQ + qb * 256, 4 + 64); continue; }
        u -= NU_A;
        if (u < NU_H) { hyena_unit(p, shm, u); continue; }
        u -= NU_H;
        if (u < NU_AC) { const int b = u >> 2, h = u & 3; diffattn_unit<0>(p, shm, b, h, ML + b * NCTX, 4); continue; }
        u -= NU_AC;
        hyena_ctx_unit(p, shm, u);
    }
}

DI void phase_bt_transpose(PP p, unsigned char* shm) {
    bf16_t* tile = (bf16_t*)shm;
    const bf16_t* BT = (const bf16_t*)(p->ws + WS_BT); bf16_t* AB = (bf16_t*)(p->ws + WS_HN);
    const int tid = tidx();
    for (int u = blockIdx.x; u < 8 * (MT / 256); u += gridDim.x) {
        const int c0 = (u & 7) * 64, t0 = (u >> 3) * 256;
        {   u32x4 v[4];
#pragma unroll
            for (int k = 0; k < 4; ++k) { const int q = tid + 512 * k; const int cr = q >> 5, tc = (q & 31) * 8; v[k] = *(const u32x4*)(BT + (size_t)(c0 + cr) * MT + t0 + tc); }
#pragma unroll
            for (int k = 0; k < 4; ++k) { const int q = tid + 512 * k; const int cr = q >> 5, tc = (q & 31) * 8; *(u32x4*)(tile + cr * 264 + tc) = v[k]; } }
        __syncthreads();
#pragma unroll
        for (int k = 0; k < 4; ++k) { const int q = tid + 512 * k; const int tr = q >> 3, cc = (q & 7) * 8; u32x4 o;
#pragma unroll
            for (int e = 0; e < 4; ++e) o[e] = (unsigned)tile[(cc + 2 * e) * 264 + tr] | ((unsigned)tile[(cc + 2 * e + 1) * 264 + tr] << 16);
            *(u32x4*)(AB + (size_t)(t0 + tr) * 1024 + 512 + c0 + cc) = o; }
        __syncthreads();
    }
}

constexpr int NA_KS = 144, NA_VS = 144;
constexpr int NA_KB = 64 * NA_KS, NA_STAGE = 2 * 64 * 144, NA_RPB = 2 * NA_STAGE;
DI void na_unit(PP p, unsigned char* shm, int u) {
    LAS unsigned char* lds = (LAS unsigned char*)shm;
    const int tid = tidx(), w = tid >> 6, lane = tid & 63, i = lane & 31, g = lane >> 5;
    const int b = u >> 8, h = (u >> 4) & 15, rg = u & 15;
    const int r = 4 * rg + (w >> 1), half = w & 1;
    float* rpb = (float*)(shm + NA_RPB);
    for (int q = tid; q < 15 * 128; q += 512) { const int ro = q >> 7, idx = (q & 127) - 48; rpb[q] = (idx >= 0 && idx < 31) ? p->in[25][(size_t)h * 465 + ro * 31 + idx] * 1.4426950408889634f : 0.f; }
    const bf16_t* QK = (const bf16_t*)(p->ws + WS_BIG);
    const bf16_t* VT = QK + (size_t)MT * 2048;
    const int c = 32 * half + i;
    const int qtok = b * SEQ + r * 64 + c;
    bf16x8 qf[4];
#pragma unroll
    for (int kk = 0; kk < 4; ++kk) qf[kk] = *(const bf16x8*)(QK + (size_t)qtok * 2048 + h * 64 + 16 * kk + 8 * g);
    const int kp = kperm(i);
    const bf16_t* gk0 = QK + (size_t)(tid >> 3) * 2048 + 1024 + h * 64 + 8 * (tid & 7);
    const bf16_t* gv0 = VT + (size_t)(h * 64 + (tid >> 3)) * MT + 8 * (tid & 7);
    const int lk0 = (tid >> 3) * NA_KS + (tid & 7) * 16, lv0 = NA_KB + (tid >> 3) * NA_VS + (tid & 7) * 16;
    FA<2> st;
#pragma unroll
    for (int dt = 0; dt < 2; ++dt)
#pragma unroll
        for (int rr = 0; rr < 16; ++rr) st.o[dt][rr] = 0.f;
    st.m = -1e30f; st.l = 0.f;
    const float cscale = 0.125f * 1.4426950408889634f;
    const int rs = min(max(r - 4, 0), 56);
    const int cs = min(max(c - 8, 0), 48);
    const int lo = cs - c + 15;
    unsigned vm0 = 0u, vm1 = 0u;
#pragma unroll
    for (int rr = 0; rr < 16; ++rr) { const int idx = 8 * g - c + 15 + 16 * (rr >> 3) + (rr & 7);
        vm0 |= ((unsigned)(idx - lo) < 16u ? 0u : 1u) << rr; vm1 |= ((unsigned)(idx + 32 - lo) < 16u ? 0u : 1u) << rr; }
    const int R0 = min(max(4 * rg - 4, 0), 56), R1 = min(max(4 * rg + 3 - 4, 0), 56) + 8;
    const int nst = 4 + (R1 - R0);
    const int ctok = ML + b * NCTX, ltok = b * SEQ + R0 * 64;
    const int aK = kp * NA_KS + 8 * g * 2;
    const int aV = NA_KB + kp * NA_VS + 8 * g * 2;
    f32x16 ol;
#pragma unroll
    for (int rr = 0; rr < 16; ++rr) ol[rr] = 0.f;
    const bf16x8 ones = {0x3F80, 0x3F80, 0x3F80, 0x3F80, 0x3F80, 0x3F80, 0x3F80, 0x3F80};
    u32x4 rk, rv;
    rk = *(const u32x4*)(gk0 + (size_t)ctok * 2048); rv = *(const u32x4*)(gv0 + ctok);
    *(LAS u32x4*)(lds + lk0) = rk; *(LAS u32x4*)(lds + lv0) = rv;
    __syncthreads();
    for (int s = 0; s < nst; ++s) {
        const bool more = s + 1 < nst;
        if (more) { const int sn = s + 1; const int tok0 = sn < 4 ? ctok + 64 * sn : ltok + 64 * (sn - 4);
            rk = *(const u32x4*)(gk0 + (size_t)tok0 * 2048); rv = *(const u32x4*)(gv0 + tok0); }
        LAS const unsigned char* sb = lds + (s & 1) * NA_STAGE;
        const int krow = R0 + (s - 4);
        const bool lat = s >= 4;
        if (!lat || (krow >= rs && krow < rs + 8)) {
            const float* brow = rpb + (lat ? (krow - r + 7) : 0) * 128 + 48 + 8 * g - c + 15;
            f32x16 sc[2];
#pragma unroll
            for (int sub = 0; sub < 2; ++sub) {
#pragma unroll
                for (int rr = 0; rr < 16; ++rr) sc[sub][rr] = 0.f;
#pragma unroll
                for (int kk = 0; kk < 4; ++kk) { const bf16x8 kf = *(LAS const bf16x8*)(sb + aK + sub * 32 * NA_KS + 32 * kk); sc[sub] = MFMA32(kf, qf[kk], sc[sub]); }
            }
            if (s == 0) {
                float mx = -1e30f;
#pragma unroll
                for (int rr = 0; rr < 16; ++rr) mx = fmaxf(mx, fmaxf(sc[0][rr], sc[1][rr]));
                st.m = fmaxf(mx, shx(mx, lane, 32)); }
            float pmax = 0.f;
#pragma unroll
            for (int sub = 0; sub < 2; ++sub) {
                const unsigned vm = sub ? vm1 : vm0;
#pragma unroll
                for (int rr = 0; rr < 16; ++rr) {
                    float v = sc[sub][rr];
                    if (lat) { const unsigned pm = (unsigned)(((int)(vm << (31 - rr))) >> 31) & 0xF149F2CAu;
                        v = v + brow[32 * sub + 16 * (rr >> 3) + (rr & 7)] + __uint_as_float(pm); }
                    sc[sub][rr] = __builtin_amdgcn_exp2f(v - st.m); st.l += sc[sub][rr];
                }
#pragma unroll
                for (int rr = 0; rr < 16; rr += 2) pmax = fmaxf(fmaxf(pmax, sc[sub][rr]), sc[sub][rr + 1]);
            }
            if (__any(pmax > 32768.f)) {
                pmax = fmaxf(pmax, shx(pmax, lane, 32));
                const float kk_ = pmax > 32768.f ? floorf(__builtin_amdgcn_logf(pmax)) : 0.f; const float f_ = __builtin_amdgcn_exp2f(-kk_);
#pragma unroll
                for (int sub = 0; sub < 2; ++sub)
#pragma unroll
                    for (int rr = 0; rr < 16; ++rr) sc[sub][rr] *= f_;
#pragma unroll
                for (int dt = 0; dt < 2; ++dt)
#pragma unroll
                    for (int rr = 0; rr < 16; ++rr) st.o[dt][rr] *= f_;
                st.l *= f_;
                st.m += kk_;
            }
            bf16x8 pf[2][2];
#pragma unroll
            for (int sub = 0; sub < 2; ++sub)
#pragma unroll
                for (int j = 0; j < 2; ++j) { u32x4 t; t[0] = pk2(sc[sub][8 * j], sc[sub][8 * j + 1]); t[1] = pk2(sc[sub][8 * j + 2], sc[sub][8 * j + 3]); t[2] = pk2(sc[sub][8 * j + 4], sc[sub][8 * j + 5]); t[3] = pk2(sc[sub][8 * j + 6], sc[sub][8 * j + 7]); pf[sub][j] = __builtin_bit_cast(bf16x8, t); }
#pragma unroll
            for (int sub = 0; sub < 2; ++sub) {
#pragma unroll
                for (int dt = 0; dt < 2; ++dt)
#pragma unroll
                    for (int j = 0; j < 2; ++j) { const bf16x8 vf = *(LAS const bf16x8*)(sb + aV + dt * 32 * NA_VS + sub * 64 + 32 * j); st.o[dt] = MFMA32(vf, pf[sub][j], st.o[dt]); }
            }
        }
        if (more) { LAS unsigned char* sn = lds + ((s + 1) & 1) * NA_STAGE; *(LAS u32x4*)(sn + lk0) = rk; *(LAS u32x4*)(sn + lv0) = rv; }
        __syncthreads();
    }
    const float inv = 1.f / (st.l + shx(st.l, lane, 32));
    bf16_t* dst = (bf16_t*)(p->ws + WS_HN) + (size_t)qtok * 1024 + h * 64;
#pragma unroll
    for (int dt = 0; dt < 2; ++dt)
#pragma unroll
        for (int rr = 0; rr < 2; ++rr) { const int dv = 32 * dt + 16 * rr + 8 * g; u32x4 o;
#pragma unroll
            for (int e = 0; e < 4; ++e) o[e] = pk2(st.o[dt][8 * rr + 2 * e] * inv, st.o[dt][8 * rr + 2 * e + 1] * inv);
            *(u32x4*)(dst + dv) = o; }
    __syncthreads();
}


#define XB_TMO      128
#define XB_XCNT(j)  (256  + 64 * (j))
#define XB_XSUB(j)  (1280 + 64 * (j))
#define XB_XGEN(j)  (2304 + 64 * (j))
#define XB_TOP      3328
#define XB_TOPGEN   3392
#define XCD_BAR_WORDS 3456
#define XB_SPIN_CAP (1u << 18)
DI unsigned xb_ld(unsigned* p)              { return __hip_atomic_load(p, __ATOMIC_RELAXED, __HIP_MEMORY_SCOPE_AGENT); }
DI unsigned xb_add(unsigned* p, unsigned v) { return __hip_atomic_fetch_add(p, v, __ATOMIC_RELAXED, __HIP_MEMORY_SCOPE_AGENT); }
DI unsigned xb_xcc_id() { return (unsigned)__builtin_amdgcn_s_getreg((3 << 11) | 20) & 0xFu; }
#define XB_SPIN(cond, bar) do { unsigned _sp = 0; while (cond) { __builtin_amdgcn_s_sleep(1); \
    if ((++_sp & 255u) == 0u) { if (xb_ld(&(bar)[XB_TMO])) break; if (_sp > XB_SPIN_CAP) { atomicAdd(&(bar)[XB_TMO], 1u); break; } } } } while (0)
struct XcdBarrier { unsigned* bar; unsigned x; volatile LAS unsigned* st; };
DI XcdBarrier xcd_barrier_post(unsigned* bar, volatile LAS unsigned* st) {
    XcdBarrier b; b.bar = bar; b.x = xb_xcc_id(); b.st = st;
    if (threadIdx.x == 0) (void)xb_add(&bar[XB_XCNT(b.x)], 1u);
    return b;
}
DI void xcd_barrier_complete(unsigned* bar, unsigned x, unsigned& nloc, unsigned& nx) {
    const unsigned G = gridDim.x * gridDim.y * gridDim.z;
    unsigned sum, cnt, mine, sp = 0u;
    for (;;) {
        sum = 0u; cnt = 0u; mine = 0u;
#pragma unroll
        for (unsigned j = 0; j < 16; ++j) { const unsigned c = xb_ld(&bar[XB_XCNT(j)]); sum += c; cnt += (c > 0u) ? 1u : 0u; mine = (j == x) ? c : mine; }
        if (sum == G) break;
        __builtin_amdgcn_s_sleep(1);
        if ((++sp & 255u) == 0u) { if (xb_ld(&bar[XB_TMO])) break; if (sp > XB_SPIN_CAP) { atomicAdd(&bar[XB_TMO], 1u); break; } }
    }
    nloc = mine > 0u ? mine : 1u; nx = cnt > 0u ? cnt : 1u;
}
DI void xcd_barrier(const XcdBarrier& b) {
    asm volatile("s_waitcnt vmcnt(0)" ::: "memory");
    __syncthreads();
    if (threadIdx.x == 0) {
        unsigned* bar = b.bar;
        __builtin_amdgcn_s_waitcnt(0);
        unsigned nloc = b.st[0], nx = b.st[1];
        if (nloc == 0u) { xcd_barrier_complete(bar, b.x, nloc, nx); b.st[0] = nloc; b.st[1] = nx; }
        const unsigned old = xb_add(&bar[XB_XSUB(b.x)], 1u);
        const unsigned gen = old / nloc;
        if (old + 1u == (gen + 1u) * nloc) {
            __builtin_amdgcn_fence(__ATOMIC_RELEASE, "agent");
            asm volatile("s_waitcnt vmcnt(0)" ::: "memory");
            const unsigned og = xb_add(&bar[XB_TOP], 1u);
            const unsigned tg = og / nx;
            if (og + 1u == (tg + 1u) * nx) xb_add(&bar[XB_TOPGEN], 1u);
            else XB_SPIN(xb_ld(&bar[XB_TOPGEN]) == tg, bar);
            __builtin_amdgcn_fence(__ATOMIC_ACQUIRE, "agent");
            xb_add(&bar[XB_XGEN(b.x)], 1u);
            asm volatile("s_waitcnt vmcnt(0)" ::: "memory");
        } else {
            XB_SPIN(xb_ld(&bar[XB_XGEN(b.x)]) == gen, bar);
            __builtin_amdgcn_fence(__ATOMIC_ACQUIRE, "agent");
            asm volatile("s_waitcnt vmcnt(0)" ::: "memory");
        }
    }
    __syncthreads();
}

#ifndef CTX_SPLITK
#define CTX_SPLITK 0
#endif
#ifndef PROBE
#define PROBE 0
#endif
__global__ __launch_bounds__(512, 2) void mega(Params p_unused) {
    PP p = (PP)__builtin_amdgcn_kernarg_segment_ptr();
#define P_FRESH() asm volatile("" : "+s"(p))
    extern __shared__ __attribute__((aligned(16))) unsigned char shm[];
    cg::grid_group grid = cg::this_grid();
    bf16_t* hn = (bf16_t*)(p->ws + WS_HN);
    bf16_t* big = (bf16_t*)(p->ws + WS_BIG);
    bf16_t* xsl = (bf16_t*)(p->ws + WS_XS); bf16_t* ctxs = xsl + (size_t)ML * D;
    const float* modp = (const float*)(p->ws + WS_MOD);
    {   volatile LAS unsigned* xst = (volatile LAS unsigned*)((LAS unsigned char*)shm + LDS_XST);
        if (threadIdx.x == 0) { xst[0] = 0u; xst[1] = 0u; }
        __syncthreads();
        if (p->ph_hi - p->ph_lo > 1) (void)xcd_barrier_post((unsigned*)(p->ws + WS_BAR), xst); }
#define XB_HERE() do { XcdBarrier _b; _b.bar = (unsigned*)(p->ws + WS_BAR); _b.x = xb_xcc_id(); _b.st = (volatile LAS unsigned*)((LAS unsigned char*)shm + LDS_XST); xcd_barrier(_b); } while (0)
#define GRID_SEAM() do { if (p->ph_hi > 4096 && rep == 0) grid.sync();   else XB_HERE(); } while (0)
    for (int ph = p->ph_lo; ph < p->ph_hi; ++ph) {
        { const int rep = 0; if (ph > p->ph_lo) GRID_SEAM(); }
        P_FRESH();
        if (ph == 0) { phase_prep(p, shm, 0); continue; }
        if (ph == 23) { phase_final_norm(p); continue; }
        const int layer = (ph - 1) / 11, s = (ph - 1) % 11;
        const bool last_lat_only = (layer == 1 && s >= 8);
        const int Mrows = last_lat_only ? ML : MT;
        const float* modl = modp + (size_t)layer * 9 * 9216;
        int reps = 1, mixmask = 7;
        if ((PROBE == 2 && (s == 1 || s == 9)) || ((PROBE == 3 || PROBE >= 9) && s == 5 && layer == 0) || (PROBE == 4 && s == 5 && layer == 0) || (PROBE == 5 && s == 5 && layer == 1) ||
            (PROBE == 6 && (s == 0 || s == 3 || s == 8)) || (PROBE == 7 && s == 4)) reps = 2;
        for (int rep = 0; rep < reps; ++rep) {
        if (rep) { XB_HERE(); if (PROBE == 3) mixmask = 1; if (PROBE == 4) mixmask = 2; }
        switch (s) {
        case 0: if (layer == 0) phase_prep(p, shm, 1); else phase_norm(p, layer, 0, MT, false); break;
        case 3: phase_norm(p, layer, 1, MT, false); break;
        case 8: phase_norm(p, layer, 2, Mrows, false); break;
        case 1: case 9: { const int f = s == 1 ? 0 : 1;
            pg8::EpiSwiglu E{big};
            run_gemm(shm, hn, (const bf16_t*)(p->ws + WS_W13T) + (size_t)(layer * 2 + f) * 5632 * 1024, Mrows, 5632, 1024, E); } break;
        case 2: case 10: { const int f = s == 2 ? 0 : 1; const int k = s == 2 ? 0 : 2;
            const bf16_t* w2t = (const bf16_t*)(p->ws + WS_W2T) + (size_t)(layer * 2 + f) * 1024 * 2816;
            pg8::EpiResid E{xsl, ctxs, modl + (3 * k + 2) * D, 0.5f};
            run_gemm(shm, big, w2t, CTX_SPLITK ? ML : Mrows, 1024, 2816, E);
            if (CTX_SPLITK && Mrows > ML) { pg8::EpiResidT<true> Ea{xsl, ctxs, modl + (3 * k + 2) * D, 0.5f};
                run_gemm_splitk<11>(shm, big, w2t, ML / 256, MC / 256, Ea); } } break;
        case 4:
            if (layer == 0) {
                pg8::EpiRope E1{big, (const float*)(p->ws + WS_ROPE)};
                run_gemm(shm, hn, (const bf16_t*)(p->ws + WS_ABIN), MT, 1024, 1024, E1);
                pg8::EpiStore E2{big + (size_t)MT * 1024, (size_t)MT, 0};
                run_gemm(shm, (const bf16_t*)(p->ws + WS_ABIN) + (size_t)1024 * 1024, hn, 2048, MT, 1024, E2, 544);
            } else {
                pg8::EpiStore E1{big, (size_t)2048, 4};
                run_gemm(shm, hn, (const bf16_t*)(p->ws + WS_NAIN), MT, 2048, 1024, E1);
                pg8::EpiStore E2{big + (size_t)MT * 2048, (size_t)MT, 0};
                run_gemm(shm, (const bf16_t*)(p->ws + WS_NAIN) + (size_t)2048 * 1024, hn, 1024, MT, 1024, E2, 1088);
            }
            break;
        case 5:
            if (layer == 0) { if (PROBE >= 9 && rep == 1) phase_ab_mix<(PROBE == 9 ? 1 : PROBE == 10 ? 2 : 0)>(p, shm, 1); else phase_ab_mix<0>(p, shm, mixmask); }
            else { for (int u0 = blockIdx.x; u0 < 2048; u0 += gridDim.x) { const int rnd = u0 >> 8, wg = u0 & 255; const int pair = (rnd * 8 + (wg & 7)) * 2 + (wg >> 7); na_unit(p, shm, pair * 16 + ((wg >> 3) & 15)); } }
            break;
        case 6: if (layer == 0) phase_bt_transpose(p, shm); break;
        case 7: { const bf16_t* wo = (const bf16_t*)(p->ws + (layer == 0 ? WS_ABOUT : WS_NAOUT));
            pg8::EpiResid E{xsl, ctxs, modl + 5 * D, 1.0f};
            run_gemm(shm, hn, wo, (CTX_SPLITK || layer == 1) ? ML : MT, 1024, 1024, E);
            if (CTX_SPLITK && layer == 0) { pg8::EpiResidT<true> Ea{xsl, ctxs, modl + 5 * D, 1.0f}; run_gemm_splitk<4>(shm, hn, wo, ML / 256, MC / 256, Ea); } } break;
        }
        }
    }
}

#ifndef N_LAUNCH_MODE
#define N_LAUNCH_MODE 0
#endif

extern "C" void kernel_launch(void* const* d_in, const int* in_sizes, int n_in, void* d_out, int out_size, void* d_ws, size_t ws_size, hipStream_t stream) {
    static int grid_blocks = 0;
    if (!grid_blocks) {
        int dev = 0, cus = 0, per_cu = 0;
        hipGetDevice(&dev);
        hipDeviceGetAttribute(&cus, hipDeviceAttributeMultiprocessorCount, dev);
        if (hipFuncSetAttribute((const void*)mega, hipFuncAttributeMaxDynamicSharedMemorySize, LDS_TOTAL) != hipSuccess) fprintf(stderr, "hipFuncSetAttribute failed\n");
        hipOccupancyMaxActiveBlocksPerMultiprocessor(&per_cu, (const void*)mega, 512, LDS_TOTAL);
        if (per_cu < 1) per_cu = 1;
        grid_blocks = cus * per_cu;
        if (ws_size < WS_END) fprintf(stderr, "workspace too small: %zu < %zu\n", ws_size, (size_t)WS_END);
    }
    Params p{};
    for (int i = 0; i < 27; ++i) p.in[i] = (const float*)d_in[i];
    p.out = (float*)d_out; p.ws = (unsigned char*)d_ws;
#if N_LAUNCH_MODE == 1
    for (int ph = 0; ph < 24; ++ph) {
        p.ph_lo = ph; p.ph_hi = ph + 1;
        hipLaunchKernelGGL(mega, dim3(grid_blocks), dim3(512), LDS_TOTAL, stream, p);
    }
#else
    p.ph_lo = 0; p.ph_hi = 24;
    hipMemsetAsync((unsigned char*)d_ws + WS_BAR, 0, 3456 * 4, stream);
    void* args[] = {&p};
    hipError_t e = hipLaunchCooperativeKernel((const void*)mega, dim3(grid_blocks), dim3(512), args, LDS_TOTAL, stream);
    if (e != hipSuccess) fprintf(stderr, "cooperative launch failed: %s (grid %d)\n", hipGetErrorString(e), grid_blocks);
#endif
}
```

```cpp
#include <hip/hip_runtime.h>
#include <hip/hip_cooperative_groups.h>
#include <cstdio>
namespace cg = cooperative_groups;

#define DI __device__ __forceinline__
#define LAS __attribute__((address_space(3)))
typedef unsigned short bf16_t;
typedef short bf16x8 __attribute__((ext_vector_type(8)));
typedef float f32x4 __attribute__((ext_vector_type(4)));
typedef float f32x16 __attribute__((ext_vector_type(16)));
typedef unsigned u32x4 __attribute__((ext_vector_type(4)));
typedef unsigned u32x2 __attribute__((ext_vector_type(2)));

constexpr int D = 1024, SEQ = 4096, NB = 8, NCTX = 256, DFF = 2816;
constexpr int ML = NB * SEQ, MC = NB * NCTX, MT = ML + MC;
constexpr int NMOD = 9;
constexpr int LDS_BYTES = 131072;
constexpr int LDS_TOTAL = 163840;
constexpr int LDS_XST = LDS_TOTAL - 16;

constexpr size_t AL(size_t x) { return (x + 255) & ~(size_t)255; }
constexpr size_t WS_CTXS = 0;
constexpr size_t WS_HN   = AL(WS_CTXS + (size_t)MC * D * 4);
constexpr size_t WS_BIG  = AL(WS_HN + (size_t)MT * D * 2);
constexpr size_t BIG_SZ  = (size_t)MT * 1024 * 2 + (size_t)2048 * MT * 2;
constexpr size_t WS_BT   = AL(WS_BIG + BIG_SZ);
constexpr size_t WS_W13T = AL(WS_BT + (size_t)512 * MT * 2);
constexpr size_t WS_W2T  = AL(WS_W13T + (size_t)4 * 5632 * 1024 * 2);
constexpr size_t WS_ABIN = AL(WS_W2T + (size_t)4 * 1024 * 2816 * 2);
constexpr size_t WS_ABOUT= AL(WS_ABIN + (size_t)3072 * 1024 * 2);
constexpr size_t WS_NAIN = AL(WS_ABOUT + (size_t)1024 * 1024 * 2);
constexpr size_t WS_NAOUT= AL(WS_NAIN + (size_t)3072 * 1024 * 2);
constexpr size_t WS_MOD  = AL(WS_NAOUT + (size_t)1024 * 1024 * 2);
constexpr size_t WS_ROPE = AL(WS_MOD + (size_t)2 * 9 * 9216 * 4);
constexpr size_t WS_HL   = AL(WS_ROPE + 64 * 16 * 2 * 4);
constexpr size_t WS_HC   = AL(WS_HL + (size_t)2048 * 4096 * 2);
constexpr size_t WS_BAR  = AL(WS_HC + (size_t)2048 * 256 * 2);
constexpr size_t WS_XS   = AL(WS_BAR + 3456 * 4);
constexpr size_t WS_END  = AL(WS_XS + (size_t)MT * D * 2);

struct Params {
    const float* in[27];
    float* out;
    unsigned char* ws;
    int ph_lo, ph_hi;
};

typedef const __attribute__((address_space(4))) Params* PP;

DI unsigned pk2(float a, float b) {
    typedef __bf16 bf2 __attribute__((ext_vector_type(2)));
    typedef float f2 __attribute__((ext_vector_type(2)));
    f2 v = {a, b};
    return __builtin_bit_cast(unsigned, __builtin_convertvector(v, bf2));
}
DI float bf2f(bf16_t h) { return __uint_as_float(((unsigned)h) << 16); }
DI float bflo(unsigned u) { return __uint_as_float(u << 16); }
DI float bfhi(unsigned u) { return __uint_as_float(u & 0xffff0000u); }
DI bf16_t f2bf(float f) { return (bf16_t)(pk2(f, 0.f) & 0xffffu); }
DI u32x4 zero4() { unsigned z = 0u; asm volatile("" : "+v"(z)); return (u32x4){z, z, z, z}; }
DI float shx(float v, int lane, int m) { return __builtin_bit_cast(float, __builtin_amdgcn_ds_bpermute((lane ^ m) << 2, __builtin_bit_cast(int, v))); }
DI float wave_sum(float v, int lane) {
#pragma unroll
    for (int o = 32; o >= 1; o >>= 1) v += shx(v, lane, o);
    return v;
}
DI float silu_f(float x) { return x * __builtin_amdgcn_rcpf(1.f + __expf(-x)); }
DI int tidx() { int t = threadIdx.x; asm volatile("" : "+v"(t)); return t; }
DI float sin_turns(float x) { return __builtin_amdgcn_sinf(x - floorf(x)); }
DI float cos_turns(float x) { return __builtin_amdgcn_cosf(x - floorf(x)); }
DI float sin_rad(float x) { return sin_turns(x * 0.15915494309189535f); }
DI int kperm(int m) { return (m & ~12) | ((m & 8) >> 1) | ((m & 4) << 1); }

namespace pg8 {
constexpr int BM = 256, BK = 64, HALF = 128, HTB = HALF * BK * 2, STAGE_BYTES = 8 * HTB, NXCD = 8, WGM = 8;
DI int lds_byte(int r, int c) { const int st = (r >> 4) * 2 + (c >> 5), rr = r & 15, cc = c & 31, ob = rr * 64 + cc * 2; return st * 1024 + (ob ^ (((ob >> 9) & 1) << 5)); }
DI void stage_rc(int b, int& R, int& C) { const int st = b / 1024, sb = b % 1024, swz = sb ^ (((sb >> 9) & 1) << 5); R = (st >> 1) * 16 + swz / 64; C = (st & 1) * 32 + (swz % 64) / 2; }
DI int perm32(int rho) { const int n = rho >> 4, i = rho & 15; return 8 * (i >> 2) + 4 * n + (i & 3); }
struct Unit { int pm, pn, ko; };
struct Gemm { const bf16_t* A; const bf16_t* Bt; int M, N, K, ld; };
struct StaticOrder {
    int nM, nN, nwg, G, c;
    DI void init(int M, int N, int G_, int c_) { nM = M / BM; nN = N / BM; nwg = nM * nN; G = G_; c = c_; }
    DI bool next(int i, Unit& u) const {
        const long L = (long)i * G + c; if (L >= nwg) return false;
        int wgid = (int)L; { const int q = nwg / NXCD, r = nwg % NXCD, xcd = wgid % NXCD, off = wgid / NXCD; wgid = (xcd < r ? xcd * (q + 1) : r * (q + 1) + (xcd - r) * q) + off; }
        const int nig = WGM * nN, gid = wgid / nig, fm = gid * WGM, gsz = (nM - fm) < WGM ? (nM - fm) : WGM;
        u.pm = fm + ((wgid % nig) % gsz); u.pn = (wgid % nig) / gsz; u.ko = 0; return true;
    }
};

template <int NKC> struct SplitKOrder {
    int pm0, nun, G, c;
    DI void init(int pm0_, int npm, int G_, int c_) { pm0 = pm0_; nun = npm * 4 * NKC; G = G_; c = c_; }
    DI bool next(int i, Unit& u) const { const int L = i * G + c; if (L >= nun) return false; u.ko = (L % NKC) * 256; const int q = L / NKC; u.pn = q & 3; u.pm = pm0 + (q >> 2); return true; }
};

template <class Epi, class Sched>
DI void gemm_phase(LAS unsigned char* lds, const Gemm g, const Sched& S, const Epi& E) {
    const int tid = tidx(), wid = __builtin_amdgcn_readfirstlane(tid >> 6), lane = tid & 63, wr = wid >> 2, wc = wid & 3, fr = lane & 15, fq = lane >> 4;
    const int K = g.K, nt = K / BK;
    unsigned voffA[2], voffB[2];
#pragma unroll
    for (int i = 0; i < 2; ++i) { int R, C; stage_rc(tid * 16 + i * 8192, R, C); const int Rb = Epi::PERM ? ((R & ~31) + perm32(R & 31)) : R;
        voffA[i] = (unsigned)(R * g.ld + C) * 2u; voffB[i] = (unsigned)(Rb * g.ld + C) * 2u; }
    const size_t kstep = (size_t)(BK * 2);
    const size_t hstep = (size_t)HALF * g.ld * 2;
    const size_t tstep = 2 * hstep;
    const unsigned ldsw = (unsigned)wid * 1024u;
    const int aoff = lds_byte(wr * 64 + fr, fq * 8), boff = lds_byte(wc * 32 + fr, fq * 8);
#define PG8_SA(b, h) (((b) * 2 + (h)) * HTB)
#define PG8_SB(b, h) ((4 + (b) * 2 + (h)) * HTB)
#define PG8_STAGE(bufoff, gbase, voff) do { _Pragma("unroll") for (int _i = 0; _i < 2; ++_i) \
        __builtin_amdgcn_global_load_lds((const unsigned*)((const char*)(gbase) + (voff)[_i]), (LAS unsigned*)(lds + (bufoff) + ldsw + _i * 8192), 16, 0, 0); } while (0)
#define PG8_LDA(dst, b, h) do { _Pragma("unroll") for (int m = 0; m < 4; ++m) _Pragma("unroll") for (int k = 0; k < 2; ++k) dst[m][k] = *(const LAS bf16x8*)(lds + PG8_SA(b, h) + aoff + m * 2048 + k * 1024); } while (0)
#define PG8_LDB(dst, b, h) do { _Pragma("unroll") for (int n = 0; n < 2; ++n) _Pragma("unroll") for (int k = 0; k < 2; ++k) dst[n][k] = *(const LAS bf16x8*)(lds + PG8_SB(b, h) + boff + n * 2048 + k * 1024); } while (0)
#define PG8_MMA(ai, bj, At, Bt) do { __builtin_amdgcn_s_setprio(1); _Pragma("unroll") for (int m = 0; m < 4; ++m) _Pragma("unroll") for (int n = 0; n < 2; ++n) _Pragma("unroll") for (int k = 0; k < 2; ++k) \
        acc[ai][bj][m][n] = __builtin_amdgcn_mfma_f32_16x16x32_bf16(Bt[n][k], At[m][k], acc[ai][bj][m][n], 0, 0, 0); __builtin_amdgcn_s_setprio(0); } while (0)
#define PG8_WAIT_V(n) asm volatile("s_waitcnt vmcnt(" #n ")" ::: "memory")
#define PG8_WAIT_L(n) asm volatile("s_waitcnt lgkmcnt(" #n ")" ::: "memory")
#define PG8_BAR __builtin_amdgcn_s_barrier()
#define PG8_SCHED __builtin_amdgcn_sched_barrier(0)
    Unit cur, nxt; int ui = 0;
    if (!S.next(0, cur)) return;
    f32x4 acc[2][2][4][2];
#pragma unroll
    for (int a = 0; a < 2; ++a)
#pragma unroll
        for (int b = 0; b < 2; ++b)
#pragma unroll
            for (int m = 0; m < 4; ++m)
#pragma unroll
                for (int n = 0; n < 2; ++n) acc[a][b][m][n] = (f32x4){0.f, 0.f, 0.f, 0.f};
    bf16x8 At[4][2], B0[2][2], B1[2][2];
    const char* cA = (const char*)g.A + (size_t)cur.pm * tstep + (size_t)cur.ko * 2; const char* cB = (const char*)g.Bt + (size_t)cur.pn * tstep + (size_t)cur.ko * 2;
    PG8_STAGE(PG8_SB(0, 0), cB, voffB); PG8_STAGE(PG8_SA(0, 0), cA, voffA); PG8_STAGE(PG8_SB(0, 1), cB + hstep, voffB); PG8_STAGE(PG8_SA(0, 1), cA + hstep, voffA);
    if (wr == 1) PG8_BAR;
    PG8_WAIT_V(4); PG8_BAR;
    PG8_STAGE(PG8_SB(1, 0), cB + kstep, voffB); PG8_STAGE(PG8_SA(1, 0), cA + kstep, voffA); PG8_STAGE(PG8_SB(1, 1), cB + hstep + kstep, voffB);
    PG8_WAIT_V(6); PG8_BAR;
    for (;;) {
        const bool has_next = S.next(ui + 1, nxt);
        const char* nA = has_next ? (const char*)g.A + (size_t)nxt.pm * tstep + (size_t)nxt.ko * 2 : cA; const char* nB = has_next ? (const char*)g.Bt + (size_t)nxt.pn * tstep + (size_t)nxt.ko * 2 : cB;
#pragma unroll 1
        for (int t = 0; t < nt; t += 2) {
            const bool last = (t == nt - 2);
            const char* a1 = cA + (size_t)(t + 1) * kstep;
            const char* a2 = last ? nA : cA + (size_t)(t + 2) * kstep; const char* b2 = last ? nB : cB + (size_t)(t + 2) * kstep;
            const char* a3 = a2 + kstep; const char* b3 = b2 + kstep;
            PG8_LDB(B0, 0, 0); PG8_SCHED; PG8_LDA(At, 0, 0); PG8_STAGE(PG8_SA(1, 1), a1 + hstep, voffA);
            PG8_WAIT_L(8); PG8_BAR; PG8_WAIT_L(0); PG8_MMA(0, 0, At, B0); PG8_BAR; PG8_SCHED;
            PG8_LDB(B1, 0, 1); PG8_STAGE(PG8_SB(0, 0), b2, voffB);
            PG8_BAR; PG8_WAIT_L(0); PG8_MMA(0, 1, At, B1); PG8_BAR;
            PG8_LDA(At, 0, 1); PG8_STAGE(PG8_SA(0, 0), a2, voffA);
            PG8_BAR; PG8_WAIT_L(0); PG8_MMA(1, 0, At, B0); PG8_BAR; PG8_SCHED;
            PG8_STAGE(PG8_SB(0, 1), b2 + hstep, voffB);
            PG8_WAIT_V(6); PG8_BAR; PG8_MMA(1, 1, At, B1); PG8_BAR;
            PG8_LDB(B0, 1, 0); PG8_SCHED; PG8_LDA(At, 1, 0); PG8_STAGE(PG8_SA(0, 1), a2 + hstep, voffA);
            PG8_WAIT_L(8); PG8_BAR; PG8_WAIT_L(0); PG8_MMA(0, 0, At, B0); PG8_BAR; PG8_SCHED;
            PG8_LDB(B1, 1, 1); PG8_STAGE(PG8_SB(1, 0), b3, voffB);
            PG8_BAR; PG8_WAIT_L(0); PG8_MMA(0, 1, At, B1); PG8_BAR;
            PG8_LDA(At, 1, 1); PG8_STAGE(PG8_SA(1, 0), a3, voffA);
            PG8_BAR; PG8_WAIT_L(0); PG8_MMA(1, 0, At, B0); PG8_BAR; PG8_SCHED;
            PG8_STAGE(PG8_SB(1, 1), b3 + hstep, voffB);
            PG8_WAIT_V(6); PG8_BAR; PG8_MMA(1, 1, At, B1); PG8_BAR;
        }
        E(acc, cur, wr, wc, fr, fq);
        if (!has_next) break;
#pragma unroll
        for (int a = 0; a < 2; ++a)
#pragma unroll
            for (int b = 0; b < 2; ++b)
#pragma unroll
                for (int m = 0; m < 4; ++m)
#pragma unroll
                    for (int n = 0; n < 2; ++n) acc[a][b][m][n] = (f32x4){0.f, 0.f, 0.f, 0.f};
        cur = nxt; cA = nA; cB = nB; ++ui;
    }
    PG8_WAIT_V(0);
    if (wr == 0) PG8_BAR;
    PG8_BAR;
#undef PG8_SA
#undef PG8_SB
#undef PG8_STAGE
#undef PG8_LDA
#undef PG8_LDB
#undef PG8_MMA
#undef PG8_WAIT_V
#undef PG8_WAIT_L
#undef PG8_BAR
#undef PG8_SCHED
}

struct EpiSwiglu {
    static constexpr bool PERM = true;
    bf16_t* H;
    DI void operator()(const f32x4 (&acc)[2][2][4][2], const Unit& u, int wr, int wc, int fr, int fq) const {
        const int row0 = u.pm * BM + wr * 64 + fr, col0 = u.pn * 128 + wc * 32 + 8 * fq;
#pragma unroll
        for (int ai = 0; ai < 2; ++ai)
#pragma unroll
            for (int m = 0; m < 4; ++m) {
                const f32x4 g0 = acc[ai][0][m][0], g1 = acc[ai][0][m][1], u0 = acc[ai][1][m][0], u1 = acc[ai][1][m][1];
                u32x4 o;
                o[0] = pk2(silu_f(g0[0]) * u0[0], silu_f(g0[1]) * u0[1]); o[1] = pk2(silu_f(g0[2]) * u0[2], silu_f(g0[3]) * u0[3]);
                o[2] = pk2(silu_f(g1[0]) * u1[0], silu_f(g1[1]) * u1[1]); o[3] = pk2(silu_f(g1[2]) * u1[2], silu_f(g1[3]) * u1[3]);
                *(u32x4*)(H + (size_t)(row0 + ai * HALF + m * 16) * DFF + col0) = o;
            }
    }
};
template <bool ATOMIC> struct EpiResidT {
    static constexpr bool PERM = true;
    bf16_t* lat; bf16_t* ctxs; const float* gate; float f;
    DI void operator()(const f32x4 (&acc)[2][2][4][2], const Unit& u, int wr, int wc, int fr, int fq) const {
        const int rt = u.pm * BM; const bool islat = rt < ML; const int bb = islat ? (rt >> 12) : 8;
        bf16_t* base = islat ? lat + (size_t)rt * D : ctxs + (size_t)(rt - ML) * D;
        const int col0 = u.pn * BM + wc * 32 + 8 * fq;
        const float* g = gate + (size_t)bb * (NMOD * D) + col0;
        f32x4 gv[2][2];
#pragma unroll
        for (int bj = 0; bj < 2; ++bj) { gv[bj][0] = *(const f32x4*)(g + bj * HALF) * f; gv[bj][1] = *(const f32x4*)(g + bj * HALF + 4) * f; }
        bf16_t* xp = base + (size_t)(wr * 64 + fr) * D + col0;
#pragma unroll
        for (int ai = 0; ai < 2; ++ai) {
            asm volatile("" : "+v"(xp));
            u32x4 xv[4][2];
#pragma unroll
            for (int m = 0; m < 4; ++m)
#pragma unroll
                for (int bj = 0; bj < 2; ++bj) xv[m][bj] = *(const u32x4*)(xp + (size_t)m * 16 * D + bj * HALF);
#pragma unroll
            for (int m = 0; m < 4; ++m)
#pragma unroll
                for (int bj = 0; bj < 2; ++bj) {
                    const f32x4 d0 = gv[bj][0] * acc[ai][bj][m][0], d1 = gv[bj][1] * acc[ai][bj][m][1];
                    const u32x4 x = xv[m][bj]; u32x4 ov;
                    ov[0] = pk2(bflo(x[0]) + d0[0], bfhi(x[0]) + d0[1]); ov[1] = pk2(bflo(x[1]) + d0[2], bfhi(x[1]) + d0[3]);
                    ov[2] = pk2(bflo(x[2]) + d1[0], bfhi(x[2]) + d1[1]); ov[3] = pk2(bflo(x[3]) + d1[2], bfhi(x[3]) + d1[3]);
                    if (!ATOMIC) *(u32x4*)(xp + (size_t)m * 16 * D + bj * HALF) = ov;
                }
            xp += 128 * D;
        }
    }
};
typedef EpiResidT<false> EpiResid;
struct EpiRope {
    static constexpr bool PERM = false;
    bf16_t* O; const float* rope;
    DI void operator()(const f32x4 (&acc)[2][2][4][2], const Unit& u, int wr, int wc, int fr, int fq) const {
        const int rt = u.pm * BM; const bool islat = rt < ML;
        const int r0 = rt + wr * 64 + fr, cb = u.pn * BM + wc * 32 + 4 * fq, ax = wc & 1;
#pragma unroll
        for (int ai = 0; ai < 2; ++ai) {
            f32x4 csa[4], csb[4];
#pragma unroll
            for (int m = 0; m < 4; ++m) { const int row = r0 + ai * HALF + m * 16; const int t = row & 4095; const int pos = ax ? (t & 63) : (t >> 6);
                csa[m] = (f32x4){1.f, 0.f, 1.f, 0.f}; csb[m] = csa[m];
                if (islat) { csa[m] = *(const f32x4*)(rope + (pos * 16 + 4 * fq) * 2); csb[m] = *(const f32x4*)(rope + (pos * 16 + 4 * fq) * 2 + 4); } }
#pragma unroll
            for (int m = 0; m < 4; ++m) {
                const int row = r0 + ai * HALF + m * 16;
                f32x4 cs0 = csa[m], cs1 = csb[m];
                if (u.pn < 2) { cs0 *= 0.18033688011112042f; cs1 *= 0.18033688011112042f; }
#pragma unroll
                for (int bj = 0; bj < 2; ++bj) {
                    const f32x4 x1 = acc[ai][bj][m][0], x2 = acc[ai][bj][m][1];
                    const float c0 = cs0[0], s0 = cs0[1], c1 = cs0[2], s1 = cs0[3], c2 = cs1[0], s2 = cs1[1], c3 = cs1[2], s3 = cs1[3];
                    u32x2 o1, o2;
                    o1[0] = pk2(x1[0] * c0 - x2[0] * s0, x1[1] * c1 - x2[1] * s1); o1[1] = pk2(x1[2] * c2 - x2[2] * s2, x1[3] * c3 - x2[3] * s3);
                    o2[0] = pk2(x1[0] * s0 + x2[0] * c0, x1[1] * s1 + x2[1] * c1); o2[1] = pk2(x1[2] * s2 + x2[2] * c2, x1[3] * s3 + x2[3] * c3);
                    bf16_t* dst = O + (size_t)row * 1024 + cb + bj * HALF;
                    *(u32x2*)dst = o1; *(u32x2*)(dst + 16) = o2;
                }
            }
        }
    }
};
struct EpiStore {
    static constexpr bool PERM = true;
    bf16_t* O; size_t ldc; int qtiles;
    DI void operator()(const f32x4 (&acc)[2][2][4][2], const Unit& u, int wr, int wc, int fr, int fq) const {
        const int row0 = u.pm * BM + wr * 64 + fr; const size_t col0 = (size_t)u.pn * BM + wc * 32 + 8 * fq; const float qs = u.pn < qtiles ? 0.18033688011112042f : 1.f;
#pragma unroll
        for (int ai = 0; ai < 2; ++ai)
#pragma unroll
            for (int m = 0; m < 4; ++m) { bf16_t* rowp = O + (size_t)(row0 + ai * HALF + m * 16) * ldc + col0;
#pragma unroll
                for (int bj = 0; bj < 2; ++bj) { const f32x4 v0 = acc[ai][bj][m][0] * qs, v1 = acc[ai][bj][m][1] * qs; u32x4 o;
                    o[0] = pk2(v0[0], v0[1]); o[1] = pk2(v0[2], v0[3]); o[2] = pk2(v1[0], v1[1]); o[3] = pk2(v1[2], v1[3]);
                    *(u32x4*)(rowp + bj * HALF) = o; } }
    }
};
}

template <class Epi>
DI void run_gemm(unsigned char* shm, const bf16_t* A, const bf16_t* Bt, int M, int N, int K, const Epi& E, int rot = 0) {
    pg8::Gemm g{A, Bt, M, N, K, K};
    const int G = (int)gridDim.x;
    pg8::StaticOrder S; S.init(M, N, G, ((int)blockIdx.x + G - rot % G) % G);
    pg8::gemm_phase<Epi, pg8::StaticOrder>((LAS unsigned char*)shm, g, S, E);
    __syncthreads();
}
template <int NKC, class Epi>
DI void run_gemm_splitk(unsigned char* shm, const bf16_t* A, const bf16_t* Bt, int pm0, int npm, const Epi& E) {
    pg8::Gemm g{A, Bt, 0, 1024, 256, NKC * 256};
    pg8::SplitKOrder<NKC> S; S.init(pm0, npm, (int)gridDim.x, (int)blockIdx.x);
    pg8::gemm_phase<Epi, pg8::SplitKOrder<NKC>>((LAS unsigned char*)shm, g, S, E);
    __syncthreads();
}

DI void transpose_tile(float* tile  , const float* src, int N, bf16_t* dst, int K, int k0, int n0, int mode, const float* rowscale = nullptr) {
    const int tid = tidx();
    {   const int kr = tid >> 6, nc = (tid & 63) * 4;
        f32x4 v[8];
#pragma unroll
        for (int q = 0; q < 8; ++q) v[q] = *(const f32x4*)(src + (size_t)(k0 + kr + 8 * q) * N + n0 + nc);
#pragma unroll
        for (int q = 0; q < 8; ++q) { const int kk_ = k0 + kr + 8 * q; const float rs_ = (rowscale && kk_ < 512) ? rowscale[kk_ & 127] : 1.f;
            float* t = tile + (kr + 8 * q) * 257 + nc; t[0] = v[q][0] * rs_; t[1] = v[q][1] * rs_; t[2] = v[q][2] * rs_; t[3] = v[q][3] * rs_; } }
    __syncthreads();
    {   const int nr = tid >> 1, kc = (tid & 1) * 32; const int n = n0 + nr;
        const int drow = mode == 0 ? n : ((n >> 7) * 256 + (n & 127) + (mode == 2 ? 128 : 0));
        bf16_t* d = dst + (size_t)drow * K + k0 + kc;
#pragma unroll
        for (int c = 0; c < 4; ++c) { u32x4 o;
#pragma unroll
            for (int i = 0; i < 4; ++i) o[i] = pk2(tile[(kc + 8 * c + 2 * i) * 257 + nr], tile[(kc + 8 * c + 2 * i + 1) * 257 + nr]);
            *(u32x4*)(d + 8 * c) = o; } }
    __syncthreads();
}

DI void prep_mod_unit(PP p, float* lds, int u) {
    const int tid = tidx(), layer = u / 36, cb = u % 36, w = tid >> 6, lane = tid & 63;
    float* s = lds;
    float* red = lds + 1024 * 12;
    for (int i = tid; i < 9 * 1024; i += 512) { const int bb = i >> 10, k = i & 1023; const float v = bb < 8 ? p->in[1][bb * 1024 + k] : p->in[3][k]; s[k * 12 + bb] = silu_f(v); }
    __syncthreads();
    const float* wp = p->in[4] + (size_t)layer * 1024 * 9216 + cb * 256 + lane * 4;
    f32x4 acc[9];
#pragma unroll
    for (int b = 0; b < 9; ++b) acc[b] = (f32x4){0.f, 0.f, 0.f, 0.f};
#pragma unroll 8
    for (int k = w; k < 1024; k += 8) { const f32x4 wv = *(const f32x4*)(wp + (size_t)k * 9216);
        const f32x4 s0 = *(const f32x4*)(s + k * 12), s1 = *(const f32x4*)(s + k * 12 + 4); const float s8 = s[k * 12 + 8];
        acc[0] += wv * s0[0]; acc[1] += wv * s0[1]; acc[2] += wv * s0[2]; acc[3] += wv * s0[3];
        acc[4] += wv * s1[0]; acc[5] += wv * s1[1]; acc[6] += wv * s1[2]; acc[7] += wv * s1[3]; acc[8] += wv * s8; }
#pragma unroll
    for (int b = 0; b < 9; ++b) *(f32x4*)(red + (w * 9 + b) * 256 + lane * 4) = acc[b];
    __syncthreads();
    float* mod = (float*)(p->ws + WS_MOD) + (size_t)layer * 9 * 9216;
    for (int i = tid; i < 9 * 256; i += 512) { const int b = i >> 8, c = i & 255; const int cg_ = cb * 256 + c; float a = p->in[5][layer * 9216 + cg_];
#pragma unroll
        for (int q = 0; q < 8; ++q) a += red[(q * 9 + b) * 256 + c];
        mod[(size_t)b * 9216 + cg_] = a; }
    __syncthreads();
}

DI void prep_filter_unit(PP p, float* lds, int n, int j0, bf16_t* out) {
    const int tid = tidx();
    float* zf = lds;
    float* hA = lds + 16 * 36;
    float* hB = hA + 16 * 64;
    float* w0s = hB + 16 * 64;
    float* w1s = w0s + 33 * 64;
    const float* w0 = p->in[16]; const float* b0 = p->in[17]; const float* w1 = p->in[18]; const float* b1 = p->in[19]; const float* fr = p->in[20]; const float* wo = p->in[21]; const float* hyb = p->in[22];
    for (int i = tid; i < 33 * 16; i += 512) *(f32x4*)(w0s + 4 * i) = *(const f32x4*)(w0 + 4 * i);
    for (int i = tid; i < 2048; i += 512) *(f32x4*)(w1s + 4 * i) = *(const f32x4*)(w1 + 4 * i);
    for (int i = tid; i < 16 * 33; i += 512) { const int jj = i / 33, e = i % 33; const int j = j0 + jj;
        const float t = (float)j / (float)(n - 1); const float wt = (float)j / (float)n;
        float v;
        if (e == 0) v = t; else { const int k = (e - 1) & 15; const float band = 1e-4f + (float)k * ((15.f - 1e-4f) / 15.f); v = e <= 16 ? cos_turns(band * wt) : -sin_turns(band * wt); }
        zf[jj * 36 + e] = v; }
    __syncthreads();
    for (int i = tid; i < 1024; i += 512) { const int jj = i >> 6, m = i & 63; float a = b0[m];
        for (int e = 0; e < 33; ++e) a += zf[jj * 36 + e] * w0s[e * 64 + m];
        hA[jj * 64 + m] = sin_rad(fr[m] * a); }
    __syncthreads();
    for (int i = tid; i < 1024; i += 512) { const int jj = i >> 6, m = i & 63; float a = b1[m];
        for (int e = 0; e < 64; ++e) a += hA[jj * 64 + e] * w1s[e * 64 + m];
        hB[jj * 64 + m] = sin_rad(fr[m] * a); }
    __syncthreads();
    for (int i = tid; i < 1024; i += 512) { const int jj = i >> 6, m = i & 63; float a = b1[64 + m];
        for (int e = 0; e < 64; ++e) a += hB[jj * 64 + e] * w1s[4096 + e * 64 + m];
        hA[jj * 64 + m] = sin_rad(fr[m] * a); }
    __syncthreads();
    const float dmin = -3.0701134573253945f, dmax = -15.350567286626972f;
    {   const int col0 = tid * 4;
        f32x4 acc[16];
#pragma unroll
        for (int jj = 0; jj < 16; ++jj) acc[jj] = (f32x4){0.f, 0.f, 0.f, 0.f};
#pragma unroll 1
        for (int k4 = 0; k4 < 16; ++k4) {
            const f32x4 wa = *(const f32x4*)(wo + (size_t)(4 * k4 + 0) * 2048 + col0), wb = *(const f32x4*)(wo + (size_t)(4 * k4 + 1) * 2048 + col0),
                        wc_ = *(const f32x4*)(wo + (size_t)(4 * k4 + 2) * 2048 + col0), wd = *(const f32x4*)(wo + (size_t)(4 * k4 + 3) * 2048 + col0);
#pragma unroll
            for (int jj = 0; jj < 16; ++jj) { const f32x4 h = *(const f32x4*)(hA + jj * 64 + 4 * k4); acc[jj] += wa * h[0] + wb * h[1] + wc_ * h[2] + wd * h[3]; }
        }
#pragma unroll
        for (int q = 0; q < 4; ++q) {
            const int col = col0 + q; const int c = col & 511, od = col >> 9;
            const float delta = fabsf(dmin + (dmax - dmin) * ((float)c / 511.f));
            float v[16];
#pragma unroll
            for (int jj = 0; jj < 16; ++jj) { const int j = j0 + jj; const float t = (float)j / (float)(n - 1); v[jj] = acc[jj][q] * __expf(-t * delta); }
            if (j0 == 0 && (od & 1) == 0) v[0] += hyb[(od >> 1) * 512 + c];
            u32x4 o0, o1;
#pragma unroll
            for (int i = 0; i < 4; ++i) { o0[i] = pk2(v[2 * i], v[2 * i + 1]); o1[i] = pk2(v[8 + 2 * i], v[8 + 2 * i + 1]); }
            bf16_t* dst = out + (size_t)col * n + j0;
            *(u32x4*)dst = o0; *(u32x4*)(dst + 8) = o1;
        }
    }
    __syncthreads();
}

DI void norm_rows(PP p, int layer, int k, bool copy, int row_begin, int nrows, int gw, int nw);
DI void phase_prep(PP p, unsigned char* shm, int stage) {
    float* lds = (float*)shm;
    constexpr int NU_MOD = 72, NU_FL = 256, NU_FC = 16, NU_ROPE = 1, NU_TR = 2624, NU_S0 = NU_MOD + NU_FL + NU_FC + NU_ROPE, NU_NORM = MT / 256;
    const int ubeg = stage == 0 ? 0 : NU_S0 - NU_NORM, uend = stage == 0 ? NU_S0 : NU_S0 + NU_TR;
    for (int u0 = ubeg + (int)blockIdx.x; u0 < uend; u0 += gridDim.x) {
        int u = u0;
        if (stage == 1 && u < NU_S0) { norm_rows(p, 0, 0, true, (u - ubeg) * 256, (u - ubeg) * 256 + 256, tidx() >> 6, 8); continue; }
        if (u < NU_MOD) { prep_mod_unit(p, lds, u); continue; }
        u -= NU_MOD;
        if (u < NU_FL) { prep_filter_unit(p, lds, 4096, u * 16, (bf16_t*)(p->ws + WS_HL)); continue; }
        u -= NU_FL;
        if (u < NU_FC) { prep_filter_unit(p, lds, 256, u * 16, (bf16_t*)(p->ws + WS_HC)); continue; }
        u -= NU_FC;
        if (u < NU_ROPE) { float* rope = (float*)(p->ws + WS_ROPE);
            for (int i = tidx(); i < 1024; i += 512) { const int pos = i >> 4, f = i & 15; const float inv = exp2f(-(float)f * (13.287712379549449f / 16.f)); const float a = (float)pos * inv * 0.15915494309189535f; rope[2 * i] = cos_turns(a); rope[2 * i + 1] = sin_turns(a); }
            continue; }
        u -= NU_ROPE;
        const float* src; bf16_t* dst; int K, N, mode, tile;
        if (u < 2112) { const int job = u / 176; tile = u % 176; const int lf = job / 3, kind = job % 3;
            if (kind < 2) { src = p->in[7 + kind] + (size_t)lf * 1024 * 2816; K = 1024; N = 2816; dst = (bf16_t*)(p->ws + WS_W13T) + (size_t)lf * 5632 * 1024; mode = 1 + kind; }
            else { src = p->in[9] + (size_t)lf * 2816 * 1024; K = 2816; N = 1024; dst = (bf16_t*)(p->ws + WS_W2T) + (size_t)lf * 1024 * 2816; mode = 0; } }
        else { u -= 2112;
            if (u < 384) { const int job = u / 192; tile = u % 192; src = p->in[job ? 23 : 10]; K = 1024; N = 3072; dst = (bf16_t*)(p->ws + (job ? WS_NAIN : WS_ABIN)); mode = 0; }
            else { u -= 384; const int job = u / 64; tile = u % 64; src = p->in[job ? 24 : 11]; K = 1024; N = 1024; dst = (bf16_t*)(p->ws + (job ? WS_NAOUT : WS_ABOUT)); mode = 0; } }
        const int ntn = N / 256; const int k0 = (tile / ntn) * 64, n0 = (tile % ntn) * 256;
        transpose_tile(lds, src, N, dst, K, k0, n0, mode, src == p->in[11] ? p->in[13] : nullptr);
    }
}

DI void norm_rows(PP p, int layer, int k, bool copy, int row_begin, int nrows, int gw, int nw) {
    const int lane = tidx() & 63;
    const float* gn = p->in[6] + (size_t)(layer * 3 + k) * D;
    const float* mod = (const float*)(p->ws + WS_MOD) + (size_t)layer * 9 * 9216;
    bf16_t* hn = (bf16_t*)(p->ws + WS_HN);
    bf16_t* xs = (bf16_t*)(p->ws + WS_XS);
    u32x4 nx[4][2];
    const int step = nw * 4;
    if (!copy && row_begin + gw * 4 < nrows) { const bf16_t* src = xs + (size_t)(row_begin + gw * 4) * D;
#pragma unroll
        for (int j = 0; j < 4; ++j)
#pragma unroll
            for (int q = 0; q < 2; ++q) nx[j][q] = *(const u32x4*)(src + (size_t)j * D + q * 512 + lane * 8); }
    for (int row0 = row_begin + gw * 4; row0 < nrows; row0 += step) {
        const bool islat = row0 < ML; const int bb = islat ? (row0 >> 12) : 8;
        float x[4][2][8]; float ss[4];
        if (copy) { const float* src = islat ? p->in[0] + (size_t)row0 * D : p->in[2] + (size_t)(row0 - ML) * D;
#pragma unroll
            for (int j = 0; j < 4; ++j)
#pragma unroll
                for (int q = 0; q < 2; ++q) { const f32x4 a = *(const f32x4*)(src + (size_t)j * D + q * 512 + lane * 8), c = *(const f32x4*)(src + (size_t)j * D + q * 512 + lane * 8 + 4);
                    for (int i = 0; i < 4; ++i) { x[j][q][i] = a[i]; x[j][q][4 + i] = c[i]; } }
        } else {
#pragma unroll
            for (int j = 0; j < 4; ++j)
#pragma unroll
                for (int q = 0; q < 2; ++q) { const u32x4 v = nx[j][q];
                    for (int i = 0; i < 4; ++i) { x[j][q][2 * i] = bflo(v[i]); x[j][q][2 * i + 1] = bfhi(v[i]); } }
            if (row0 + step < nrows) { const bf16_t* src = xs + (size_t)(row0 + step) * D;
#pragma unroll
                for (int j = 0; j < 4; ++j)
#pragma unroll
                    for (int q = 0; q < 2; ++q) nx[j][q] = *(const u32x4*)(src + (size_t)j * D + q * 512 + lane * 8); }
        }
        const float* sh = mod + (size_t)bb * 9216 + (3 * k) * D; const float* sc = sh + D;
        float gg[2][8], s0[2][8];
#pragma unroll
        for (int q = 0; q < 2; ++q)
#pragma unroll
            for (int hh = 0; hh < 2; ++hh) { const int c = q * 512 + lane * 8 + 4 * hh; const f32x4 g = *(const f32x4*)(gn + c), s1 = *(const f32x4*)(sc + c), sv = *(const f32x4*)(sh + c);
                for (int i = 0; i < 4; ++i) { gg[q][4 * hh + i] = g[i] * (1.f + s1[i]); s0[q][4 * hh + i] = sv[i]; } }
#pragma unroll
        for (int j = 0; j < 4; ++j) { float a = 0.f;
#pragma unroll
            for (int q = 0; q < 2; ++q)
#pragma unroll
                for (int i = 0; i < 8; ++i) a += x[j][q][i] * x[j][q][i];
            ss[j] = rsqrtf(wave_sum(a, lane) * (1.f / D) + 1e-6f); }
        if (copy) {
#pragma unroll
            for (int j = 0; j < 4; ++j)
#pragma unroll
                for (int q = 0; q < 2; ++q) { u32x4 o; for (int i = 0; i < 4; ++i) o[i] = pk2(x[j][q][2 * i], x[j][q][2 * i + 1]);
                    *(u32x4*)(xs + (size_t)(row0 + j) * D + q * 512 + lane * 8) = o; } }
#pragma unroll
        for (int j = 0; j < 4; ++j)
#pragma unroll
            for (int q = 0; q < 2; ++q) { u32x4 o;
                for (int i = 0; i < 4; ++i) o[i] = pk2(x[j][q][2 * i] * ss[j] * gg[q][2 * i] + s0[q][2 * i], x[j][q][2 * i + 1] * ss[j] * gg[q][2 * i + 1] + s0[q][2 * i + 1]);
                *(u32x4*)(hn + (size_t)(row0 + j) * D + q * 512 + lane * 8) = o; }
    }
}
DI void phase_norm(PP p, int layer, int k, int nrows, bool copy) { norm_rows(p, layer, k, copy, 0, nrows, (int)blockIdx.x * 8 + (tidx() >> 6), (int)gridDim.x * 8); }
DI void phase_final_norm(PP p) {
    const int lane = tidx() & 63, gw = blockIdx.x * 8 + (tidx() >> 6), nw = gridDim.x * 8;
    const float* gn = p->in[26];
    const bf16_t* xs = (const bf16_t*)(p->ws + WS_XS);
    for (int row0 = gw * 4; row0 < ML; row0 += nw * 4) {
        float x[4][2][8];
#pragma unroll
        for (int j = 0; j < 4; ++j)
#pragma unroll
            for (int q = 0; q < 2; ++q) { const u32x4 v = *(const u32x4*)(xs + (size_t)(row0 + j) * D + q * 512 + lane * 8);
                for (int i = 0; i < 4; ++i) { x[j][q][2 * i] = bflo(v[i]); x[j][q][2 * i + 1] = bfhi(v[i]); } }
        float g[2][8];
#pragma unroll
        for (int q = 0; q < 2; ++q)
#pragma unroll
            for (int hh = 0; hh < 2; ++hh) { const f32x4 gv = *(const f32x4*)(gn + q * 512 + lane * 8 + 4 * hh); for (int i = 0; i < 4; ++i) g[q][4 * hh + i] = gv[i]; }
#pragma unroll
        for (int j = 0; j < 4; ++j) { float a = 0.f;
#pragma unroll
            for (int q = 0; q < 2; ++q)
#pragma unroll
                for (int i = 0; i < 8; ++i) a += x[j][q][i] * x[j][q][i];
            const float rstd = rsqrtf(wave_sum(a, lane) * (1.f / D) + 1e-6f);
            float* dst = p->out + (size_t)(row0 + j) * D;
#pragma unroll
            for (int q = 0; q < 2; ++q)
#pragma unroll
                for (int hh = 0; hh < 2; ++hh) { f32x4 y; for (int i = 0; i < 4; ++i) y[i] = x[j][q][4 * hh + i] * rstd * g[q][4 * hh + i];
                    *(f32x4*)(dst + q * 512 + lane * 8 + 4 * hh) = y; } }
    }
}

#define MFMA32(a, b, c) __builtin_amdgcn_mfma_f32_32x32x16_bf16((a), (b), (c), 0, 0, 0)
template <int DVT> struct FA { f32x16 o[DVT]; float m, l; };

template <int DVT, bool NAB>
DI void fa_tile(FA<DVT>& st, const bf16x8 (&qf)[4], const bf16x8 (&kf)[4], const bf16x8 (&vf)[DVT][2], float cscale,
                const float* rpbrow  , int idx0, int lo) {
    f32x16 s;
#pragma unroll
    for (int r = 0; r < 16; ++r) s[r] = 0.f;
#pragma unroll
    for (int kk = 0; kk < 4; ++kk) s = MFMA32(kf[kk], qf[kk], s);
    float sv[16]; float mx = -1e30f;
#pragma unroll
    for (int r = 0; r < 16; ++r) {
        float v = s[r] * cscale;
        if (NAB) { const int idx = idx0 + 16 * (r >> 3) + (r & 7); const bool valid = (unsigned)(idx - lo) < 16u; v = valid ? v + rpbrow[valid ? idx : 0] : -1e30f; }
        sv[r] = v; mx = fmaxf(mx, v);
    }
    mx = fmaxf(mx, __shfl_xor(mx, 32));
    const float mnew = fmaxf(st.m, mx);
    if (__any(mnew > st.m)) {
        const float alpha = __builtin_amdgcn_exp2f(st.m - mnew);
        st.l *= alpha;
#pragma unroll
        for (int dt = 0; dt < DVT; ++dt)
#pragma unroll
            for (int r = 0; r < 16; ++r) st.o[dt][r] *= alpha;
        st.m = mnew;
    }
    float ps = 0.f;
#pragma unroll
    for (int r = 0; r < 16; ++r) { sv[r] = __builtin_amdgcn_exp2f(sv[r] - st.m); ps += sv[r]; }
    st.l += ps;
    bf16x8 pf[2];
#pragma unroll
    for (int j = 0; j < 2; ++j) { u32x4 t; t[0] = pk2(sv[8 * j], sv[8 * j + 1]); t[1] = pk2(sv[8 * j + 2], sv[8 * j + 3]); t[2] = pk2(sv[8 * j + 4], sv[8 * j + 5]); t[3] = pk2(sv[8 * j + 6], sv[8 * j + 7]); pf[j] = __builtin_bit_cast(bf16x8, t); }
#pragma unroll
    for (int dt = 0; dt < DVT; ++dt)
#pragma unroll
        for (int j = 0; j < 2; ++j) st.o[dt] = MFMA32(vf[dt][j], pf[j], st.o[dt]);
}

constexpr int DA_KS = 272, DA_VS = 144;
constexpr int DA_KB = 64 * DA_KS, DA_VB = 128 * DA_VS, DA_STAGE = DA_KB + DA_VB, DA_Q = 2 * DA_STAGE, DA_QB = 256 * DA_KS;
static_assert(DA_Q + DA_QB <= LDS_XST, "lds");
template <int VAR>
DI void diffattn_unit(PP p, unsigned char* shm, int b, int h, int qtok0, int nkt) {
    LAS unsigned char* lds = (LAS unsigned char*)shm;
    const int tid = tidx(), w = tid >> 6, lane = tid & 63, i = lane & 31, g = lane >> 5, map = w >> 2, qs = w & 3;
    const bf16_t* QK = (const bf16_t*)(p->ws + WS_BIG);
    const bf16_t* VT = QK + (size_t)MT * 1024;
    const int kp = kperm(i);
    const unsigned gko = (unsigned)((tid >> 4) * 1024 + 512 + h * 128 + 8 * (tid & 15));
    const unsigned gvo = (unsigned)((h * 128 + (tid >> 3)) * MT + 8 * (tid & 7));
    const int lkw = (tid >> 4) * DA_KS + (tid & 15) * 16, lvw = DA_KB + (tid >> 3) * DA_VS + (tid & 7) * 16;
    const int ctok = ML + b * NCTX, ltok = b * SEQ;
#pragma unroll
    for (int qq = 0; qq < 8; ++qq) { const int c = tid + 512 * qq; const int row = c >> 4, ch = c & 15;
        const u32x4 v = *(const u32x4*)(QK + (size_t)(qtok0 + row) * 1024 + h * 128 + 8 * ch);
        *(LAS u32x4*)(lds + DA_Q + row * DA_KS + ch * 16) = v; }
    u32x4 rr_[2];
#define DA_TOK(kt_) ((kt_) < 4 ? ctok + 64 * (kt_) : ltok + 64 * ((kt_) - 4))
#define DA_LOADK(kt_) do { const unsigned tok0 = (unsigned)DA_TOK(kt_); rr_[0] = *(const u32x4*)(QK + (gko + tok0 * 1024u)); rr_[1] = *(const u32x4*)(QK + (gko + (tok0 + 32u) * 1024u)); } while (0)
#define DA_LOADV(kt_) do { const unsigned tok0 = (unsigned)DA_TOK(kt_); rr_[0] = *(const u32x4*)(VT + (gvo + tok0)); rr_[1] = *(const u32x4*)(VT + (gvo + 64u * MT + tok0)); } while (0)
#define DA_STOREK(st_) do { LAS unsigned char* _sn = lds + (st_) * DA_STAGE; *(LAS u32x4*)(_sn + lkw) = rr_[0]; *(LAS u32x4*)(_sn + lkw + 32 * DA_KS) = rr_[1]; } while (0)
#define DA_STOREV(st_) do { LAS unsigned char* _sn = lds + (st_) * DA_STAGE; *(LAS u32x4*)(_sn + lvw) = rr_[0]; *(LAS u32x4*)(_sn + lvw + 64 * DA_VS) = rr_[1]; } while (0)
    DA_LOADK(0); DA_STOREK(0); DA_LOADV(0); DA_STOREV(0);
    __syncthreads();
    const int aK = kp * DA_KS + (map * 64 + 8 * g) * 2;
    const int aV = DA_KB + kp * DA_VS + 8 * g * 2;
    const int aQ = DA_Q + (64 * qs + i) * DA_KS + (map * 64 + 8 * g) * 2;
    f32x16 o[2][4];
#pragma unroll
    for (int qt = 0; qt < 2; ++qt)
#pragma unroll
        for (int dt = 0; dt < 4; ++dt)
#pragma unroll
            for (int r = 0; r < 16; ++r) o[qt][dt][r] = 0.f;
    float mref[2], lsum[2] = {0.f, 0.f}, pmp[2] = {0.f, 0.f};
    {
        float mx[2] = {-1e30f, -1e30f};
#pragma unroll
        for (int sub = 0; sub < 2; ++sub) { f32x16 S[2];
#pragma unroll
            for (int qt = 0; qt < 2; ++qt)
#pragma unroll
                for (int r = 0; r < 16; ++r) S[qt][r] = 0.f;
#pragma unroll
            for (int kk = 0; kk < 4; ++kk) { const bf16x8 kf = *(LAS const bf16x8*)(lds + aK + sub * 32 * DA_KS + 32 * kk);
#pragma unroll
                for (int qt = 0; qt < 2; ++qt) { const bf16x8 qf = *(LAS const bf16x8*)(lds + aQ + qt * 32 * DA_KS + 32 * kk); S[qt] = MFMA32(kf, qf, S[qt]); } }
#pragma unroll
            for (int qt = 0; qt < 2; ++qt)
#pragma unroll
                for (int r = 0; r < 16; ++r) mx[qt] = fmaxf(mx[qt], S[qt][r]); }
#pragma unroll
        for (int qt = 0; qt < 2; ++qt) mref[qt] = fmaxf(mx[qt], shx(mx[qt], lane, 32)); }
    for (int kt = 0; kt < nkt; ++kt) {
        const bool more = kt + 1 < nkt;
        if (__any(fmaxf(pmp[0], pmp[1]) > 32768.f)) {
#pragma unroll
            for (int qt = 0; qt < 2; ++qt) { const float pm = fmaxf(pmp[qt], shx(pmp[qt], lane, 32));
                const float kk_ = pm > 32768.f ? floorf(__builtin_amdgcn_logf(pm)) : 0.f; const float f_ = __builtin_amdgcn_exp2f(-kk_);
#pragma unroll
                for (int dt = 0; dt < 4; ++dt)
#pragma unroll
                    for (int r = 0; r < 16; ++r) o[qt][dt][r] *= f_;
                lsum[qt] *= f_; mref[qt] += kk_; } }
        pmp[0] = 0.f; pmp[1] = 0.f;
        LAS const unsigned char* sb = lds + (kt & 1) * DA_STAGE;
#pragma unroll
        for (int sub = 0; sub < 2; ++sub) {
            if (more) { if (sub == 0) DA_LOADK(kt + 1); else DA_LOADV(kt + 1); }
            f32x16 S[2];
#pragma unroll
            for (int qt = 0; qt < 2; ++qt)
#pragma unroll
                for (int r = 0; r < 16; ++r) S[qt][r] = 0.f;
#pragma unroll
            for (int kk = 0; kk < 4; ++kk) { const bf16x8 kf = *(LAS const bf16x8*)(sb + aK + sub * 32 * DA_KS + 32 * kk);
#pragma unroll
                for (int qt = 0; qt < 2; ++qt) { const bf16x8 qf = *(LAS const bf16x8*)(lds + aQ + qt * 32 * DA_KS + 32 * kk); S[qt] = MFMA32(kf, qf, S[qt]); }
                if (kk != 3) __builtin_amdgcn_sched_barrier(0); }
            bf16x8 pf[2][2];
#pragma unroll
            for (int qt = 0; qt < 2; ++qt) {
#pragma unroll
                for (int r = 0; r < 16; ++r) { S[qt][r] = __builtin_amdgcn_exp2f(S[qt][r] - mref[qt]); lsum[qt] += S[qt][r]; }
#pragma unroll
                for (int r = 0; r < 16; r += 2) pmp[qt] = fmaxf(fmaxf(pmp[qt], S[qt][r]), S[qt][r + 1]);
#pragma unroll
                for (int j = 0; j < 2; ++j) { u32x4 t; t[0] = pk2(S[qt][8 * j], S[qt][8 * j + 1]); t[1] = pk2(S[qt][8 * j + 2], S[qt][8 * j + 3]); t[2] = pk2(S[qt][8 * j + 4], S[qt][8 * j + 5]); t[3] = pk2(S[qt][8 * j + 6], S[qt][8 * j + 7]); pf[qt][j] = __builtin_bit_cast(bf16x8, t); }
            }
#pragma unroll
            for (int dt = 0; dt < 4; ++dt)
#pragma unroll
                for (int j = 0; j < 2; ++j) { const bf16x8 vf = *(LAS const bf16x8*)(sb + aV + dt * 32 * DA_VS + sub * 64 + 32 * j);
                    o[0][dt] = MFMA32(vf, pf[0][j], o[0][dt]); o[1][dt] = MFMA32(vf, pf[1][j], o[1][dt]);
                    if (j == 1) __builtin_amdgcn_sched_barrier(0); }
            if (more) { if (sub == 0) DA_STOREK((kt + 1) & 1); else DA_STOREV((kt + 1) & 1); }
        }
        __syncthreads();
    }
#undef DA_TOK
#undef DA_LOADK
#undef DA_LOADV
#undef DA_STOREK
#undef DA_STOREV
    const float* lp = p->in[12];
    float la = wave_sum(lp[lane] * lp[64 + lane], lane), lb = wave_sum(lp[128 + lane] * lp[192 + lane], lane);
    const float lam = __expf(la) - __expf(lb) + 0.2f;
    float* ob = (float*)shm;
    float inv[2];
#pragma unroll
    for (int qt = 0; qt < 2; ++qt) inv[qt] = 1.f / (lsum[qt] + shx(lsum[qt], lane, 32));
    if (map == 1) {
#pragma unroll
        for (int qt = 0; qt < 2; ++qt)
#pragma unroll
            for (int dt = 0; dt < 4; ++dt)
#pragma unroll
                for (int r = 0; r < 16; ++r) ob[(32 * dt + 16 * (r >> 3) + 8 * g + (r & 7)) * 256 + 64 * qs + 32 * qt + i] = o[qt][dt][r] * inv[qt];
    }
    __syncthreads();
    if (map == 0) {
#pragma unroll
        for (int qt = 0; qt < 2; ++qt) {
            float ss = 0.f;
#pragma unroll
            for (int dt = 0; dt < 4; ++dt) {
#pragma unroll
                for (int r = 0; r < 16; ++r) { const float v = o[qt][dt][r] * inv[qt] - lam * ob[(32 * dt + 16 * (r >> 3) + 8 * g + (r & 7)) * 256 + 64 * qs + 32 * qt + i]; o[qt][dt][r] = v; ss += v * v; }
                __builtin_amdgcn_sched_barrier(0); }
            ss += shx(ss, lane, 32);
            const float rstd = rsqrtf(ss * (1.f / 128.f) + 1e-6f) * 0.8f;
            bf16_t* dst = (bf16_t*)(p->ws + (VAR ? WS_END : WS_HN)) + (size_t)(qtok0 + 64 * qs + 32 * qt + i) * 1024 + h * 128;
#pragma unroll
            for (int dt = 0; dt < 4; ++dt)
#pragma unroll
                for (int rr = 0; rr < 2; ++rr) { const int dv = 32 * dt + 16 * rr + 8 * g; u32x4 ov;
#pragma unroll
                    for (int e = 0; e < 4; ++e) ov[e] = pk2(o[qt][dt][8 * rr + 2 * e] * rstd, o[qt][dt][8 * rr + 2 * e + 1] * rstd);
                    *(u32x4*)(dst + dv) = ov; }
        }
    }
    __syncthreads();
}

constexpr int VP = 4616, VPAD = 256;
constexpr int HY_G0 = 8 * VP * 2;
constexpr int GLEN = 8192 + 64;
constexpr int HY_G1 = HY_G0 + GLEN * 2 + 64;
static_assert(HY_G1 + GLEN * 2 <= LDS_BYTES, "lds");

DI void shortconv8(const bf16_t* row, int t, int n, float w0, float w1, float w2, float bias, float (&o)[8]) {
    const u32x4 c = *(const u32x4*)(row + t);
    float x[10];
    x[0] = t > 0 ? bf2f(row[t - 1]) : 0.f; x[9] = t + 8 < n ? bf2f(row[t + 8]) : 0.f;
#pragma unroll
    for (int e = 0; e < 4; ++e) { x[1 + 2 * e] = bflo(c[e]); x[2 + 2 * e] = bfhi(c[e]); }
#pragma unroll
    for (int e = 0; e < 8; ++e) o[e] = w0 * x[e] + w1 * x[e + 1] + w2 * x[e + 2] + bias;
}

DI void hy_fill_g(LAS unsigned char* lds, const bf16_t* hf, const bf16_t* hb) {
    const int t = tidx();
    const u32x4 F = *(const u32x4*)(hf + 8 * t), B = *(const u32x4*)(hb + 8 * t);
    const unsigned fn = t < 511 ? hf[8 * t + 8] : 0u, bn = t < 511 ? hb[8 * t + 8] : 0u, f0 = hf[0];
    u32x4 g1f, g0f, g0b, g1b;
    g1f[0] = (F[3] >> 16) | (F[3] << 16); g1f[1] = (F[2] >> 16) | (F[2] << 16); g1f[2] = (F[1] >> 16) | (F[1] << 16); g1f[3] = (F[0] >> 16) | (F[0] << 16);
    g0f[0] = fn | (F[3] & 0xffff0000u); g0f[1] = (F[3] & 0xffffu) | (F[2] & 0xffff0000u); g0f[2] = (F[2] & 0xffffu) | (F[1] & 0xffff0000u); g0f[3] = (F[1] & 0xffffu) | (F[0] & 0xffff0000u);
    g0b = B; if (t == 0) g0b[0] = (B[0] & 0xffff0000u) | f0;
    g1b[0] = (B[0] >> 16) | (B[1] << 16); g1b[1] = (B[1] >> 16) | (B[2] << 16); g1b[2] = (B[2] >> 16) | (B[3] << 16); g1b[3] = (B[3] >> 16) | (bn << 16);
    *(LAS u32x4*)(lds + HY_G1 + 2 * (4088 - 8 * t)) = g1f; *(LAS u32x4*)(lds + HY_G0 + 2 * (4088 - 8 * t)) = g0f;
    *(LAS u32x4*)(lds + HY_G0 + 2 * (4096 + 8 * t)) = g0b; *(LAS u32x4*)(lds + HY_G1 + 2 * (4096 + 8 * t)) = g1b;
    if (t < 16) *(LAS u32x4*)(lds + (t < 8 ? HY_G0 : HY_G1) + 2 * (8192 + 8 * (t & 7))) = zero4();
}

DI void hy_conv(LAS const unsigned char* lds, int w, int lane, f32x16 (&acc)[2][2]) {
    const int i = lane & 31, g = lane >> 5, pi = kperm(i);
#pragma unroll
    for (int mt = 0; mt < 2; ++mt)
#pragma unroll
        for (int nt = 0; nt < 2; ++nt)
#pragma unroll
            for (int r = 0; r < 16; ++r) acc[mt][nt][r] = 0.f;
    const int abase = ((pi & 1) ? HY_G1 : HY_G0) + 2 * (4096 - pi + 8 * g - (pi & 1));
    const int bbase = ((i & 7) * VP + VPAD + 64 * (8 * w + (i >> 3)) + 8 * g) * 2;
    for (int dl = 8 * w - 63; dl <= 8 * w + 7; ++dl) {
        bf16x8 af[2][4];
#pragma unroll
        for (int mt = 0; mt < 2; ++mt)
#pragma unroll
            for (int kk = 0; kk < 4; ++kk) {
                LAS const unsigned* ap = (LAS const unsigned*)(lds + abase - 128 * dl - 64 * mt + 32 * kk);
                u32x4 t; t[0] = ap[0]; t[1] = ap[1]; t[2] = ap[2]; t[3] = ap[3];
                af[mt][kk] = __builtin_bit_cast(bf16x8, t);
            }
#pragma unroll
        for (int nt = 0; nt < 2; ++nt) {
            if (dl >= 8 * w + 4 * nt - 63 && dl <= 8 * w + 4 * nt + 3) {
                bf16x8 bfr[4];
#pragma unroll
                for (int kk = 0; kk < 4; ++kk) bfr[kk] = *(LAS const bf16x8*)(lds + bbase + 512 * nt - 128 * dl + 32 * kk);
#pragma unroll
                for (int mt = 0; mt < 2; ++mt)
#pragma unroll
                    for (int kk = 0; kk < 4; ++kk) acc[mt][nt] = MFMA32(af[mt][kk], bfr[kk], acc[mt][nt]);
            }
        }
    }
}

DI void hyena_unit(PP p, unsigned char* shm, int c) {
    LAS unsigned char* lds = (LAS unsigned char*)shm;
    const int tid = tidx(), w = tid >> 6, lane = tid & 63, i = lane & 31, g = lane >> 5;
    const bf16_t* UT = (const bf16_t*)(p->ws + WS_BIG) + (size_t)MT * 1024 + (size_t)512 * MT;
    const float* cw = p->in[14]; const float* cbias = p->in[15];
    const bf16_t* HL = (const bf16_t*)(p->ws + WS_HL);
    for (int q = tid; q < 8 * 64; q += 512) { const int b = q >> 6, e = q & 63; const int off = (e < 32 ? e * 8 : 4096 + VPAD + (e - 32) * 8);
        *(LAS u32x4*)(lds + (b * VP + off) * 2) = zero4(); }
    {   const int ch = 1024 + c; const float w0 = cw[ch], w1 = cw[1536 + ch], w2 = cw[3072 + ch], bs = cbias[ch];
#pragma unroll
        for (int qq = 0; qq < 8; ++qq) { const int q = tid + 512 * qq; const int b = q >> 9, t = (q & 511) * 8; float o[8];
            shortconv8(UT + (size_t)ch * MT + b * SEQ, t, SEQ, w0, w1, w2, bs, o);
            u32x4 v; for (int e = 0; e < 4; ++e) v[e] = pk2(o[2 * e], o[2 * e + 1]);
            *(LAS u32x4*)(lds + (b * VP + VPAD + t) * 2) = v; } }
    hy_fill_g(lds, HL + (size_t)(0 * 512 + c) * 4096, HL + (size_t)(1 * 512 + c) * 4096);
    __syncthreads();
    f32x16 acc[2][2];
    hy_conv(lds, w, lane, acc);
    __syncthreads();
    {   const int ch = c; const float w0 = cw[ch], w1 = cw[1536 + ch], w2 = cw[3072 + ch], bs = cbias[ch]; const int b = i & 7;
#pragma unroll
        for (int mt = 0; mt < 2; ++mt)
#pragma unroll
            for (int nt = 0; nt < 2; ++nt)
#pragma unroll
                for (int rr = 0; rr < 2; ++rr) { const int t = 64 * (8 * w + 4 * nt + (i >> 3)) + 32 * mt + 16 * rr + 8 * g; float o[8];
                    shortconv8(UT + (size_t)ch * MT + b * SEQ, t, SEQ, w0, w1, w2, bs, o);
                    u32x4 v; for (int e = 0; e < 4; ++e) v[e] = pk2(o[2 * e] * acc[mt][nt][8 * rr + 2 * e], o[2 * e + 1] * acc[mt][nt][8 * rr + 2 * e + 1]);
                    *(LAS u32x4*)(lds + (b * VP + VPAD + t) * 2) = v; } }
    hy_fill_g(lds, HL + (size_t)(2 * 512 + c) * 4096, HL + (size_t)(3 * 512 + c) * 4096);
    __syncthreads();
    hy_conv(lds, w, lane, acc);
    {   const int ch = 512 + c; const float w0 = cw[ch], w1 = cw[1536 + ch], w2 = cw[3072 + ch], bs = cbias[ch]; const int b = i & 7;
        bf16_t* BT = (bf16_t*)(p->ws + WS_BT) + (size_t)c * MT;
#pragma unroll
        for (int mt = 0; mt < 2; ++mt)
#pragma unroll
            for (int nt = 0; nt < 2; ++nt)
#pragma unroll
                for (int rr = 0; rr < 2; ++rr) { const int t = 64 * (8 * w + 4 * nt + (i >> 3)) + 32 * mt + 16 * rr + 8 * g; float o[8];
                    shortconv8(UT + (size_t)ch * MT + b * SEQ, t, SEQ, w0, w1, w2, bs, o);
#pragma unroll
                    for (int e = 0; e < 8; ++e) acc[mt][nt][8 * rr + e] *= o[e]; }
#pragma unroll
        for (int mt = 0; mt < 2; ++mt)
#pragma unroll
            for (int nt = 0; nt < 2; ++nt)
#pragma unroll
                for (int rr = 0; rr < 2; ++rr) { const int t = 64 * (8 * w + 4 * nt + (i >> 3)) + 32 * mt + 16 * rr + 8 * g;
                    u32x4 v; for (int e = 0; e < 4; ++e) v[e] = pk2(acc[mt][nt][8 * rr + 2 * e], acc[mt][nt][8 * rr + 2 * e + 1]);
                    *(u32x4*)(BT + b * SEQ + t) = v; } }
    __syncthreads();
}

DI void hyena_ctx_unit(PP p, unsigned char* shm, int c) {
    float* lds = (float*)shm;
    float* vv = lds; float* x1 = lds + 2048; float* x2 = lds + 4096; float* zz = lds + 6144; float* g1 = lds + 8192; float* g2 = g1 + 512;
    const int tid = tidx();
    const bf16_t* UT = (const bf16_t*)(p->ws + WS_BIG) + (size_t)MT * 1024 + (size_t)512 * MT;
    const float* cw = p->in[14]; const float* cbias = p->in[15];
    const bf16_t* HC = (const bf16_t*)(p->ws + WS_HC);
    for (int q = tid; q < 3 * 2048; q += 512) { const int part = q >> 11, r = q & 2047, b = r >> 8, t = r & 255; const int ch = part * 512 + c;
        const bf16_t* row = UT + (size_t)ch * MT + ML + b * NCTX;
        const float xm = t > 0 ? bf2f(row[t - 1]) : 0.f, x0 = bf2f(row[t]), xp = t < 255 ? bf2f(row[t + 1]) : 0.f;
        const float v = cw[ch] * xm + cw[1536 + ch] * x0 + cw[3072 + ch] * xp + cbias[ch];
        (part == 0 ? x1 : part == 1 ? x2 : vv)[r] = v; }
    for (int q = tid; q < 1024; q += 512) { const int o = q >> 9, e = q & 511; const int d = e - 256;
        float v = 0.f;
        if (d >= 0 && d < 256) v = bf2f(HC[(size_t)((o * 2 + 0) * 512 + c) * 256 + d]); else if (d < 0 && d > -256) v = bf2f(HC[(size_t)((o * 2 + 1) * 512 + c) * 256 - d]);
        (o ? g2 : g1)[e] = v; }
    __syncthreads();
    for (int q = tid; q < 2048; q += 512) { const int b = q >> 8, t = q & 255; float a = 0.f;
        for (int s = 0; s < 256; ++s) a += g1[t - s + 256] * vv[b * 256 + s];
        zz[q] = x1[q] * a; }
    __syncthreads();
    bf16_t* BT = (bf16_t*)(p->ws + WS_BT) + (size_t)c * MT + ML;
    for (int q = tid; q < 2048; q += 512) { const int b = q >> 8, t = q & 255; float a = 0.f;
        for (int s = 0; s < 256; ++s) a += g2[t - s + 256] * zz[b * 256 + s];
        BT[q] = f2bf(x2[q] * a); }
    __syncthreads();
}

template <int VAR>
DI void phase_ab_mix(PP p, unsigned char* shm, int mask) {
    constexpr int NU_A = 512, NU_H = 512, NU_AC = 32, NU_HC = 512;
    for (int u0 = blockIdx.x; u0 < NU_A + NU_H + NU_AC + NU_HC; u0 += gridDim.x) {
        int u = u0;
        if (!(mask & 1) && u < NU_A) continue;
        if (!(mask & 2) && u >= NU_A && u < NU_A + NU_H) continue;
        if (!(mask & 4) && u >= NU_A + NU_H) continue;
        if (u < NU_A) { const int rnd = u >> 8, wg = u & 255; const int pair = rnd * 16 + (wg & 7) * 2 + (wg >> 7), qb = (wg >> 3) & 15;
            const int b = pair >> 2, h = pair & 3; diffattn_unit<VAR>(p, shm, b, h, b * SEQ + qb * 256, 4 + 64); continue; }
        u -= NU_A;
        if (u < NU_H) { hyena_unit(p, shm, u); continue; }
        u -= NU_H;
        if (u < NU_AC) { const int b = u >> 2, h = u & 3; diffattn_unit<0>(p, shm, b, h, ML + b * NCTX, 4); continue; }
        u -= NU_AC;
        hyena_ctx_unit(p, shm, u);
    }
}

DI void phase_bt_transpose(PP p, unsigned char* shm) {
    bf16_t* tile = (bf16_t*)shm;
    const bf16_t* BT = (const bf16_t*)(p->ws + WS_BT); bf16_t* AB = (bf16_t*)(p->ws + WS_HN);
    const int tid = tidx();
    for (int u = blockIdx.x; u < 8 * (MT / 256); u += gridDim.x) {
        const int c0 = (u & 7) * 64, t0 = (u >> 3) * 256;
        {   u32x4 v[4];
#pragma unroll
            for (int k = 0; k < 4; ++k) { const int q = tid + 512 * k; const int cr = q >> 5, tc = (q & 31) * 8; v[k] = *(const u32x4*)(BT + (size_t)(c0 + cr) * MT + t0 + tc); }
#pragma unroll
            for (int k = 0; k < 4; ++k) { const int q = tid + 512 * k; const int cr = q >> 5, tc = (q & 31) * 8; *(u32x4*)(tile + cr * 264 + tc) = v[k]; } }
        __syncthreads();
#pragma unroll
        for (int k = 0; k < 4; ++k) { const int q = tid + 512 * k; const int tr = q >> 3, cc = (q & 7) * 8; u32x4 o;
#pragma unroll
            for (int e = 0; e < 4; ++e) o[e] = (unsigned)tile[(cc + 2 * e) * 264 + tr] | ((unsigned)tile[(cc + 2 * e + 1) * 264 + tr] << 16);
            *(u32x4*)(AB + (size_t)(t0 + tr) * 1024 + 512 + c0 + cc) = o; }
        __syncthreads();
    }
}

constexpr int NA_KS = 144, NA_VS = 144;
constexpr int NA_KB = 64 * NA_KS, NA_STAGE = 2 * 64 * 144, NA_RPB = 2 * NA_STAGE;
DI void na_unit(PP p, unsigned char* shm, int u) {
    LAS unsigned char* lds = (LAS unsigned char*)shm;
    const int tid = tidx(), w = tid >> 6, lane = tid & 63, i = lane & 31, g = lane >> 5;
    const int b = u >> 8, h = (u >> 4) & 15, rg = u & 15;
    const int r = 4 * rg + (w >> 1), half = w & 1;
    float* rpb = (float*)(shm + NA_RPB);
    for (int q = tid; q < 15 * 128; q += 512) { const int ro = q >> 7, idx = (q & 127) - 48; rpb[q] = (idx >= 0 && idx < 31) ? p->in[25][(size_t)h * 465 + ro * 31 + idx] * 1.4426950408889634f : 0.f; }
    const bf16_t* QK = (const bf16_t*)(p->ws + WS_BIG);
    const bf16_t* VT = QK + (size_t)MT * 2048;
    const int c = 32 * half + i;
    const int qtok = b * SEQ + r * 64 + c;
    bf16x8 qf[4];
#pragma unroll
    for (int kk = 0; kk < 4; ++kk) qf[kk] = *(const bf16x8*)(QK + (size_t)qtok * 2048 + h * 64 + 16 * kk + 8 * g);
    const int kp = kperm(i);
    const bf16_t* gk0 = QK + (size_t)(tid >> 3) * 2048 + 1024 + h * 64 + 8 * (tid & 7);
    const bf16_t* gv0 = VT + (size_t)(h * 64 + (tid >> 3)) * MT + 8 * (tid & 7);
    const int lk0 = (tid >> 3) * NA_KS + (tid & 7) * 16, lv0 = NA_KB + (tid >> 3) * NA_VS + (tid & 7) * 16;
    FA<2> st;
#pragma unroll
    for (int dt = 0; dt < 2; ++dt)
#pragma unroll
        for (int rr = 0; rr < 16; ++rr) st.o[dt][rr] = 0.f;
    st.m = -1e30f; st.l = 0.f;
    const float cscale = 0.125f * 1.4426950408889634f;
    const int rs = min(max(r - 4, 0), 56);
    const int cs = min(max(c - 8, 0), 48);
    const int lo = cs - c + 15;
    unsigned vm0 = 0u, vm1 = 0u;
#pragma unroll
    for (int rr = 0; rr < 16; ++rr) { const int idx = 8 * g - c + 15 + 16 * (rr >> 3) + (rr & 7);
        vm0 |= ((unsigned)(idx - lo) < 16u ? 0u : 1u) << rr; vm1 |= ((unsigned)(idx + 32 - lo) < 16u ? 0u : 1u) << rr; }
    const int R0 = min(max(4 * rg - 4, 0), 56), R1 = min(max(4 * rg + 3 - 4, 0), 56) + 8;
    const int nst = 4 + (R1 - R0);
    const int ctok = ML + b * NCTX, ltok = b * SEQ + R0 * 64;
    const int aK = kp * NA_KS + 8 * g * 2;
    const int aV = NA_KB + kp * NA_VS + 8 * g * 2;
    f32x16 ol;
#pragma unroll
    for (int rr = 0; rr < 16; ++rr) ol[rr] = 0.f;
    const bf16x8 ones = {0x3F80, 0x3F80, 0x3F80, 0x3F80, 0x3F80, 0x3F80, 0x3F80, 0x3F80};
    u32x4 rk, rv;
    rk = *(const u32x4*)(gk0 + (size_t)ctok * 2048); rv = *(const u32x4*)(gv0 + ctok);
    *(LAS u32x4*)(lds + lk0) = rk; *(LAS u32x4*)(lds + lv0) = rv;
    __syncthreads();
    for (int s = 0; s < nst; ++s) {
        const bool more = s + 1 < nst;
        if (more) { const int sn = s + 1; const int tok0 = sn < 4 ? ctok + 64 * sn : ltok + 64 * (sn - 4);
            rk = *(const u32x4*)(gk0 + (size_t)tok0 * 2048); rv = *(const u32x4*)(gv0 + tok0); }
        LAS const unsigned char* sb = lds + (s & 1) * NA_STAGE;
        const int krow = R0 + (s - 4);
        const bool lat = s >= 4;
        if (!lat || (krow >= rs && krow < rs + 8)) {
            const float* brow = rpb + (lat ? (krow - r + 7) : 0) * 128 + 48 + 8 * g - c + 15;
            f32x16 sc[2];
#pragma unroll
            for (int sub = 0; sub < 2; ++sub) {
#pragma unroll
                for (int rr = 0; rr < 16; ++rr) sc[sub][rr] = 0.f;
#pragma unroll
                for (int kk = 0; kk < 4; ++kk) { const bf16x8 kf = *(LAS const bf16x8*)(sb + aK + sub * 32 * NA_KS + 32 * kk); sc[sub] = MFMA32(kf, qf[kk], sc[sub]); }
            }
            if (s == 0) {
                float mx = -1e30f;
#pragma unroll
                for (int rr = 0; rr < 16; ++rr) mx = fmaxf(mx, fmaxf(sc[0][rr], sc[1][rr]));
                st.m = fmaxf(mx, shx(mx, lane, 32)); }
            float pmax = 0.f;
#pragma unroll
            for (int sub = 0; sub < 2; ++sub) {
                const unsigned vm = sub ? vm1 : vm0;
#pragma unroll
                for (int rr = 0; rr < 16; ++rr) {
                    float v = sc[sub][rr];
                    if (lat) { const unsigned pm = (unsigned)(((int)(vm << (31 - rr))) >> 31) & 0xF149F2CAu;
                        v = v + brow[32 * sub + 16 * (rr >> 3) + (rr & 7)] + __uint_as_float(pm); }
                    sc[sub][rr] = __builtin_amdgcn_exp2f(v - st.m); st.l += sc[sub][rr];
                }
#pragma unroll
                for (int rr = 0; rr < 16; rr += 2) pmax = fmaxf(fmaxf(pmax, sc[sub][rr]), sc[sub][rr + 1]);
            }
            if (__any(pmax > 32768.f)) {
                pmax = fmaxf(pmax, shx(pmax, lane, 32));
                const float kk_ = pmax > 32768.f ? floorf(__builtin_amdgcn_logf(pmax)) : 0.f; const float f_ = __builtin_amdgcn_exp2f(-kk_);
#pragma unroll
                for (int sub = 0; sub < 2; ++sub)
#pragma unroll
                    for (int rr = 0; rr < 16; ++rr) sc[sub][rr] *= f_;
#pragma unroll
                for (int dt = 0; dt < 2; ++dt)
#pragma unroll
                    for (int rr = 0; rr < 16; ++rr) st.o[dt][rr] *= f_;
                st.l *= f_;
                st.m += kk_;
            }
            bf16x8 pf[2][2];
#pragma unroll
            for (int sub = 0; sub < 2; ++sub)
#pragma unroll
                for (int j = 0; j < 2; ++j) { u32x4 t; t[0] = pk2(sc[sub][8 * j], sc[sub][8 * j + 1]); t[1] = pk2(sc[sub][8 * j + 2], sc[sub][8 * j + 3]); t[2] = pk2(sc[sub][8 * j + 4], sc[sub][8 * j + 5]); t[3] = pk2(sc[sub][8 * j + 6], sc[sub][8 * j + 7]); pf[sub][j] = __builtin_bit_cast(bf16x8, t); }
#pragma unroll
            for (int sub = 0; sub < 2; ++sub) {
#pragma unroll
                for (int dt = 0; dt < 2; ++dt)
#pragma unroll
                    for (int j = 0; j < 2; ++j) { const bf16x8 vf = *(LAS const bf16x8*)(sb + aV + dt * 32 * NA_VS + sub * 64 + 32 * j); st.o[dt] = MFMA32(vf, pf[sub][j], st.o[dt]); }
            }
        }
        if (more) { LAS unsigned char* sn = lds + ((s + 1) & 1) * NA_STAGE; *(LAS u32x4*)(sn + lk0) = rk; *(LAS u32x4*)(sn + lv0) = rv; }
        __syncthreads();
    }
    const float inv = 1.f / (st.l + shx(st.l, lane, 32));
    bf16_t* dst = (bf16_t*)(p->ws + WS_HN) + (size_t)qtok * 1024 + h * 64;
#pragma unroll
    for (int dt = 0; dt < 2; ++dt)
#pragma unroll
        for (int rr = 0; rr < 2; ++rr) { const int dv = 32 * dt + 16 * rr + 8 * g; u32x4 o;
#pragma unroll
            for (int e = 0; e < 4; ++e) o[e] = pk2(st.o[dt][8 * rr + 2 * e] * inv, st.o[dt][8 * rr + 2 * e + 1] * inv);
            *(u32x4*)(dst + dv) = o; }
    __syncthreads();
}


#define XB_TMO      128
#define XB_XCNT(j)  (256  + 64 * (j))
#define XB_XSUB(j)  (1280 + 64 * (j))
#define XB_XGEN(j)  (2304 + 64 * (j))
#define XB_TOP      3328
#define XB_TOPGEN   3392
#define XCD_BAR_WORDS 3456
#define XB_SPIN_CAP (1u << 18)
DI unsigned xb_ld(unsigned* p)              { return __hip_atomic_load(p, __ATOMIC_RELAXED, __HIP_MEMORY_SCOPE_AGENT); }
DI unsigned xb_add(unsigned* p, unsigned v) { return __hip_atomic_fetch_add(p, v, __ATOMIC_RELAXED, __HIP_MEMORY_SCOPE_AGENT); }
DI unsigned xb_xcc_id() { return (unsigned)__builtin_amdgcn_s_getreg((3 << 11) | 20) & 0xFu; }
#define XB_SPIN(cond, bar) do { unsigned _sp = 0; while (cond) { __builtin_amdgcn_s_sleep(1); \
    if ((++_sp & 255u) == 0u) { if (xb_ld(&(bar)[XB_TMO])) break; if (_sp > XB_SPIN_CAP) { atomicAdd(&(bar)[XB_TMO], 1u); break; } } } } while (0)
struct XcdBarrier { unsigned* bar; unsigned x; volatile LAS unsigned* st; };
DI XcdBarrier xcd_barrier_post(unsigned* bar, volatile LAS unsigned* st) {
    XcdBarrier b; b.bar = bar; b.x = xb_xcc_id(); b.st = st;
    if (threadIdx.x == 0) (void)xb_add(&bar[XB_XCNT(b.x)], 1u);
    return b;
}
DI void xcd_barrier_complete(unsigned* bar, unsigned x, unsigned& nloc, unsigned& nx) {
    const unsigned G = gridDim.x * gridDim.y * gridDim.z;
    unsigned sum, cnt, mine, sp = 0u;
    for (;;) {
        sum = 0u; cnt = 0u; mine = 0u;
#pragma unroll
        for (unsigned j = 0; j < 16; ++j) { const unsigned c = xb_ld(&bar[XB_XCNT(j)]); sum += c; cnt += (c > 0u) ? 1u : 0u; mine = (j == x) ? c : mine; }
        if (sum == G) break;
        __builtin_amdgcn_s_sleep(1);
        if ((++sp & 255u) == 0u) { if (xb_ld(&bar[XB_TMO])) break; if (sp > XB_SPIN_CAP) { atomicAdd(&bar[XB_TMO], 1u); break; } }
    }
    nloc = mine > 0u ? mine : 1u; nx = cnt > 0u ? cnt : 1u;
}
DI void xcd_barrier(const XcdBarrier& b) {
    asm volatile("s_waitcnt vmcnt(0)" ::: "memory");
    __syncthreads();
    if (threadIdx.x == 0) {
        unsigned* bar = b.bar;
        __builtin_amdgcn_s_waitcnt(0);
        unsigned nloc = b.st[0], nx = b.st[1];
        if (nloc == 0u) { xcd_barrier_complete(bar, b.x, nloc, nx); b.st[0] = nloc; b.st[1] = nx; }
        const unsigned old = xb_add(&bar[XB_XSUB(b.x)], 1u);
        const unsigned gen = old / nloc;
        if (old + 1u == (gen + 1u) * nloc) {
            __builtin_amdgcn_fence(__ATOMIC_RELEASE, "agent");
            asm volatile("s_waitcnt vmcnt(0)" ::: "memory");
            const unsigned og = xb_add(&bar[XB_TOP], 1u);
            const unsigned tg = og / nx;
            if (og + 1u == (tg + 1u) * nx) xb_add(&bar[XB_TOPGEN], 1u);
            else XB_SPIN(xb_ld(&bar[XB_TOPGEN]) == tg, bar);
            __builtin_amdgcn_fence(__ATOMIC_ACQUIRE, "agent");
            xb_add(&bar[XB_XGEN(b.x)], 1u);
            asm volatile("s_waitcnt vmcnt(0)" ::: "memory");
        } else {
            XB_SPIN(xb_ld(&bar[XB_XGEN(b.x)]) == gen, bar);
            __builtin_amdgcn_fence(__ATOMIC_ACQUIRE, "agent");
            asm volatile("s_waitcnt vmcnt(0)" ::: "memory");
        }
    }
    __syncthreads();
}

#ifndef CTX_SPLITK
#define CTX_SPLITK 0
#endif
#ifndef PROBE
#define PROBE 0
#endif
__global__ __launch_bounds__(512, 2) void mega(Params p_unused) {
    PP p = (PP)__builtin_amdgcn_kernarg_segment_ptr();
#define P_FRESH() asm volatile("" : "+s"(p))
    extern __shared__ __attribute__((aligned(16))) unsigned char shm[];
    cg::grid_group grid = cg::this_grid();
    bf16_t* hn = (bf16_t*)(p->ws + WS_HN);
    bf16_t* big = (bf16_t*)(p->ws + WS_BIG);
    bf16_t* xsl = (bf16_t*)(p->ws + WS_XS); bf16_t* ctxs = xsl + (size_t)ML * D;
    const float* modp = (const float*)(p->ws + WS_MOD);
    {   volatile LAS unsigned* xst = (volatile LAS unsigned*)((LAS unsigned char*)shm + LDS_XST);
        if (threadIdx.x == 0) { xst[0] = 0u; xst[1] = 0u; }
        __syncthreads();
        if (p->ph_hi - p->ph_lo > 1) (void)xcd_barrier_post((unsigned*)(p->ws + WS_BAR), xst); }
#define XB_HERE() do { XcdBarrier _b; _b.bar = (unsigned*)(p->ws + WS_BAR); _b.x = xb_xcc_id(); _b.st = (volatile LAS unsigned*)((LAS unsigned char*)shm + LDS_XST); xcd_barrier(_b); } while (0)
#define GRID_SEAM() do { if (p->ph_hi > 4096 && rep == 0) grid.sync();   else XB_HERE(); } while (0)
    for (int ph = p->ph_lo; ph < p->ph_hi; ++ph) {
        { const int rep = 0; if (ph > p->ph_lo) GRID_SEAM(); }
        P_FRESH();
        if (ph == 0) { phase_prep(p, shm, 0); continue; }
        if (ph == 23) { phase_final_norm(p); continue; }
        const int layer = (ph - 1) / 11, s = (ph - 1) % 11;
        const bool last_lat_only = (layer == 1 && s >= 8);
        const int Mrows = last_lat_only ? ML : MT;
        const float* modl = modp + (size_t)layer * 9 * 9216;
        int reps = 1, mixmask = 7;
        if ((PROBE == 2 && (s == 1 || s == 9)) || ((PROBE == 3 || PROBE >= 9) && s == 5 && layer == 0) || (PROBE == 4 && s == 5 && layer == 0) || (PROBE == 5 && s == 5 && layer == 1) ||
            (PROBE == 6 && (s == 0 || s == 3 || s == 8)) || (PROBE == 7 && s == 4)) reps = 2;
        for (int rep = 0; rep < reps; ++rep) {
        if (rep) { XB_HERE(); if (PROBE == 3) mixmask = 1; if (PROBE == 4) mixmask = 2; }
        switch (s) {
        case 0: if (layer == 0) phase_prep(p, shm, 1); else phase_norm(p, layer, 0, MT, false); break;
        case 3: phase_norm(p, layer, 1, MT, false); break;
        case 8: phase_norm(p, layer, 2, Mrows, false); break;
        case 1: case 9: { const int f = s == 1 ? 0 : 1;
            pg8::EpiSwiglu E{big};
            run_gemm(shm, hn, (const bf16_t*)(p->ws + WS_W13T) + (size_t)(layer * 2 + f) * 5632 * 1024, Mrows, 5632, 1024, E); } break;
        case 2: case 10: { const int f = s == 2 ? 0 : 1; const int k = s == 2 ? 0 : 2;
            const bf16_t* w2t = (const bf16_t*)(p->ws + WS_W2T) + (size_t)(layer * 2 + f) * 1024 * 2816;
            pg8::EpiResid E{xsl, ctxs, modl + (3 * k + 2) * D, 0.5f};
            run_gemm(shm, big, w2t, CTX_SPLITK ? ML : Mrows, 1024, 2816, E);
            if (CTX_SPLITK && Mrows > ML) { pg8::EpiResidT<true> Ea{xsl, ctxs, modl + (3 * k + 2) * D, 0.5f};
                run_gemm_splitk<11>(shm, big, w2t, ML / 256, MC / 256, Ea); } } break;
        case 4:
            if (layer == 0) {
                pg8::EpiRope E1{big, (const float*)(p->ws + WS_ROPE)};
                run_gemm(shm, hn, (const bf16_t*)(p->ws + WS_ABIN), MT, 1024, 1024, E1);
                pg8::EpiStore E2{big + (size_t)MT * 1024, (size_t)MT, 0};
                run_gemm(shm, (const bf16_t*)(p->ws + WS_ABIN) + (size_t)1024 * 1024, hn, 2048, MT, 1024, E2, 544);
            } else {
                pg8::EpiStore E1{big, (size_t)2048, 4};
                run_gemm(shm, hn, (const bf16_t*)(p->ws + WS_NAIN), MT, 2048, 1024, E1);
                pg8::EpiStore E2{big + (size_t)MT * 2048, (size_t)MT, 0};
                run_gemm(shm, (const bf16_t*)(p->ws + WS_NAIN) + (size_t)2048 * 1024, hn, 1024, MT, 1024, E2, 1088);
            }
            break;
        case 5:
            if (layer == 0) { if (PROBE >= 9 && rep == 1) phase_ab_mix<(PROBE == 9 ? 1 : PROBE == 10 ? 2 : 0)>(p, shm, 1); else phase_ab_mix<0>(p, shm, mixmask); }
            else { for (int u0 = blockIdx.x; u0 < 2048; u0 += gridDim.x) { const int rnd = u0 >> 8, wg = u0 & 255; const int pair = (rnd * 8 + (wg & 7)) * 2 + (wg >> 7); na_unit(p, shm, pair * 16 + ((wg >> 3) & 15)); } }
            break;
        case 6: if (layer == 0) phase_bt_transpose(p, shm); break;
        case 7: { const bf16_t* wo = (const bf16_t*)(p->ws + (layer == 0 ? WS_ABOUT : WS_NAOUT));
            pg8::EpiResid E{xsl, ctxs, modl + 5 * D, 1.0f};
            run_gemm(shm, hn, wo, (CTX_SPLITK || layer == 1) ? ML : MT, 1024, 1024, E);
            if (CTX_SPLITK && layer == 0) { pg8::EpiResidT<true> Ea{xsl, ctxs, modl + 5 * D, 1.0f}; run_gemm_splitk<4>(shm, hn, wo, ML / 256, MC / 256, Ea); } } break;
        }
        }
    }
}

#ifndef N_LAUNCH_MODE
#define N_LAUNCH_MODE 0
#endif

extern "C" void kernel_launch(void* const* d_in, const int* in_sizes, int n_in, void* d_out, int out_size, void* d_ws, size_t ws_size, hipStream_t stream) {
    static int grid_blocks = 0;
    if (!grid_blocks) {
        int dev = 0, cus = 0, per_cu = 0;
        hipGetDevice(&dev);
        hipDeviceGetAttribute(&cus, hipDeviceAttributeMultiprocessorCount, dev);
        if (hipFuncSetAttribute((const void*)mega, hipFuncAttributeMaxDynamicSharedMemorySize, LDS_TOTAL) != hipSuccess) fprintf(stderr, "hipFuncSetAttribute failed\n");
        hipOccupancyMaxActiveBlocksPerMultiprocessor(&per_cu, (const void*)mega, 512, LDS_TOTAL);
        if (per_cu < 1) per_cu = 1;
        grid_blocks = cus * per_cu;
        if (ws_size < WS_END) fprintf(stderr, "workspace too small: %zu < %zu\n", ws_size, (size_t)WS_END);
    }
    Params p{};
    for (int i = 0; i < 27; ++i) p.in[i] = (const float*)d_in[i];
    p.out = (float*)d_out; p.ws = (unsigned char*)d_ws;
#if N_LAUNCH_MODE == 1
    for (int ph = 0; ph < 24; ++ph) {
        p.ph_lo = ph; p.ph_hi = ph + 1;
        hipLaunchKernelGGL(mega, dim3(grid_blocks), dim3(512), LDS_TOTAL, stream, p);
    }
#else
    p.ph_lo = 0; p.ph_hi = 24;
    hipMemsetAsync((unsigned char*)d_ws + WS_BAR, 0, 3456 * 4, stream);
    void* args[] = {&p};
    hipError_t e = hipLaunchCooperativeKernel((const void*)mega, dim3(grid_blocks), dim3(512), args, LDS_TOTAL, stream);
    if (e != hipSuccess) fprintf(stderr, "cooperative launch failed: %s (grid %d)\n", hipGetErrorString(e), grid_blocks);
#endif
}
```
